# Optimizing an MI355X kernel written in HIP

```python
import math
import jax, jax.numpy as jnp
from jax import lax
import numpy as np

D_MODEL = 1024
BATCH = 4
SEQ = 8192
DEPTH = 4

MEM_LEN = 256
N_MIXERS = 3
MIX_W = 3 * D_MODEL // 4
XATTN_HEADS = 4
XATTN_W = D_MODEL - MIX_W
XATTN_HD = XATTN_W // XATTN_HEADS
DA_HD = 64
DA_HEADS = MIX_W // (2 * DA_HD)
Q_BLOCK = 128
N_BUCKETS = 32
MAX_DISTANCE = 128
HG_DK = 128
HG_HEADS = MIX_W // HG_DK
HG_DV = MIX_W // HG_HEADS
HG_CHUNK = 64
CONV_W = 3
D_FF = ((8 * D_MODEL // 3 + 255) // 256) * 256
LN_EPS = 1e-5
ALPHA = (2 * DEPTH) ** 0.25
BETA = (8 * DEPTH) ** -0.25
N_ATTN = (DEPTH + 2) // 3
N_HGRN = (DEPTH + 1) // 3
N_CONV = DEPTH // 3
ATTN_IN = 3 * MIX_W + XATTN_W
HGRN_IN = 5 * MIX_W + XATTN_W
CONV_IN = 3 * MIX_W + XATTN_W

kernel_name = 'hybrid_diffattn_hgrn2_shortconv_encoder'


def _layer_norm(x, g, b):
    xf = x.astype(jnp.float32)
    xc = xf - jnp.mean(xf, -1, keepdims=True)
    var = jnp.mean(xc * xc, -1, keepdims=True)
    y = xc * lax.rsqrt(var + LN_EPS) * g.astype(jnp.float32) + b.astype(jnp.float32)
    return y.astype(x.dtype)


def _rms_norm(x, g):
    xf = x.astype(jnp.float32)
    y = xf * lax.rsqrt(jnp.mean(xf * xf, -1, keepdims=True) + LN_EPS)
    return (y * g.astype(jnp.float32)).astype(x.dtype)


def _dwconv3(x, w):
    xp = jnp.pad(x, ((0, 0), (1, 1), (0, 0)))
    return xp[:, :-2] * w[0] + xp[:, 1:-1] * w[1] + xp[:, 2:] * w[2]


def _t5_bucket(rel):
    half = N_BUCKETS // 2
    max_exact = half // 2
    ret = jnp.where(rel > 0, half, 0)
    n = jnp.abs(rel)
    nf = jnp.maximum(n, 1).astype(jnp.float32)
    large = max_exact + (jnp.log(nf / max_exact) / math.log(MAX_DISTANCE / max_exact)
                         * (half - max_exact)).astype(jnp.int32)
    large = jnp.minimum(large, half - 1)
    return ret + jnp.where(n < max_exact, n, large)


def _diff_attention(p, lam_params, subln, rel_bias, layer):
    b, s, _ = p.shape
    q, k, v = jnp.split(p, 3, axis=-1)
    q = q.reshape(b, s, DA_HEADS, 2, DA_HD) * (DA_HD ** -0.5)
    k = k.reshape(b, s, DA_HEADS, 2, DA_HD)
    v = v.reshape(b, s, DA_HEADS, 2 * DA_HD)
    lam_init = 0.8 - 0.6 * math.exp(-0.3 * layer)
    lp = lam_params.astype(jnp.float32)
    lam = jnp.exp(jnp.sum(lp[0] * lp[1])) - jnp.exp(jnp.sum(lp[2] * lp[3])) + lam_init
    n_blk = s // Q_BLOCK
    q_blocks = q.reshape(b, n_blk, Q_BLOCK, DA_HEADS, 2, DA_HD).transpose(1, 0, 2, 3, 4, 5)
    k_pos = jnp.arange(s, dtype=jnp.int32)
    table = rel_bias.astype(jnp.float32)

    def block(args):
        qb, blk = args
        q_pos = blk * Q_BLOCK + jnp.arange(Q_BLOCK, dtype=jnp.int32)
        bias = table[_t5_bucket(k_pos[None, :] - q_pos[:, None])].transpose(2, 0, 1)
        logits = jnp.einsum('bqhmd,bkhmd->bmhqk', qb, k).astype(jnp.float32) + bias
        probs = jax.nn.softmax(logits, axis=-1)
        w = (probs[:, 0] - lam * probs[:, 1]).astype(v.dtype)
        return jnp.einsum('bhqk,bkhe->bqhe', w, v)

    o = lax.map(block, (q_blocks, jnp.arange(n_blk, dtype=jnp.int32)))
    o = o.transpose(1, 0, 2, 3, 4).reshape(b, s, DA_HEADS, 2 * DA_HD)
    o = _rms_norm(o, subln) * (1.0 - lam_init)
    return o.reshape(b, s, MIX_W)


def _hgrn2(p, lower_bounds, norm_w, layer):
    b, s, _ = p.shape
    f32 = jnp.float32
    q, i, g, f_fw, f_bw = jnp.split(p, 5, axis=-1)
    lbw = jax.nn.softmax(lower_bounds.astype(f32), axis=0)
    lb = (jnp.cumsum(lbw, axis=0) - lbw[0])[layer][:, None, None, :]
    z = jnp.stack([f_fw, jnp.flip(f_bw, 1)]).astype(f32)
    log_f = jnp.logaddexp(jnp.log(lb), jnp.log1p(-lb) + jax.nn.log_sigmoid(z))
    k = -jnp.expm1(log_f)
    qd = jax.nn.silu(jnp.stack([q, jnp.flip(q, 1)]).astype(f32)) * (HG_DK ** -0.5)
    vd = jnp.stack([i, jnp.flip(i, 1)]).astype(f32)

    def to_chunks(t, d):
        return t.reshape(2 * b, s // HG_CHUNK, HG_CHUNK, HG_HEADS, d).transpose(1, 0, 3, 2, 4)

    mask = jnp.tril(jnp.ones((HG_CHUNK, HG_CHUNK), dtype=bool))

    def step(state, xs):
        qc, kc, vc, gc = xs
        cum = jnp.cumsum(gc, axis=2)
        rel = jnp.where(mask[:, :, None], cum[:, :, :, None, :] - cum[:, :, None, :, :], -jnp.inf)
        attn = jnp.einsum('nhtk,nhtsk,nhsk->nhts', qc, jnp.exp(rel), kc)
        o = attn @ vc + jnp.einsum('nhtk,nhkv->nhtv', qc * jnp.exp(cum), state)
        last = cum[:, :, -1:, :]
        state = (jnp.exp(last[:, :, 0, :])[..., None] * state
                 + jnp.einsum('nhsk,nhsv->nhkv', kc * jnp.exp(last - cum), vc))
        return state, o

    state0 = jnp.zeros((2 * b, HG_HEADS, HG_DK, HG_DV), f32)
    _, o = lax.scan(step, state0, (to_chunks(qd, HG_DK), to_chunks(k, HG_DK),
                                   to_chunks(vd, HG_DV), to_chunks(log_f, HG_DK)))
    o = o.transpose(1, 0, 3, 2, 4).reshape(2, b, s, HG_HEADS, HG_DV)
    o = o[0] + jnp.flip(o[1], 1)
    o = _rms_norm(o, norm_w.reshape(HG_HEADS, HG_DV)).reshape(b, s, MIX_W)
    return (o * jax.nn.silu(g.astype(f32))).astype(p.dtype)


def _short_conv(p, conv_w):
    gb, gc, h = jnp.split(p, 3, axis=-1)
    return gb * _dwconv3(gc * h, conv_w)


def _memory_attention(q, mem, w_kv):
    b, s, _ = q.shape
    m = mem.shape[1]
    km, vm = jnp.split(mem @ w_kv, 2, axis=-1)
    q = q.reshape(b, s, XATTN_HEADS, XATTN_HD) * (XATTN_HD ** -0.5)
    km = km.reshape(b, m, XATTN_HEADS, XATTN_HD)
    vm = vm.reshape(b, m, XATTN_HEADS, XATTN_HD)
    logits = jnp.einsum('bshd,bmhd->bhsm', q, km).astype(jnp.float32)
    probs = jax.nn.softmax(logits, axis=-1).astype(vm.dtype)
    return jnp.einsum('bhsm,bmhd->bshd', probs, vm).reshape(b, s, XATTN_W)


def _conv_ffn(x, w_up, w_conv, w_down):
    h = _dwconv3(x @ w_up, w_conv)
    a, v = jnp.split(h, 2, axis=-1)
    return (jax.nn.silu(a) * v) @ w_down


def setup_inputs(seed: int = 0) -> dict:
    key = jax.random.key(seed)
    ks = jax.random.split(key, 18)

    def nrm(k, shape, scale):
        return jax.random.normal(k, shape, jnp.float32) * scale

    return {
        'x': nrm(ks[0], (BATCH, SEQ, D_MODEL), 1.0),
        'mem': nrm(ks[1], (BATCH, MEM_LEN, D_MODEL), 1.0),
        'rel_bias': nrm(ks[2], (N_BUCKETS, DA_HEADS), 0.5),
        'attn_w_in': nrm(ks[3], (N_ATTN, D_MODEL, ATTN_IN), D_MODEL ** -0.5),
        'attn_lambda': nrm(ks[4], (N_ATTN, 4, DA_HD), 0.1),
        'attn_subln': 1.0 + nrm(ks[5], (N_ATTN, 2 * DA_HD), 0.02),
        'hgrn_w_in': nrm(ks[6], (N_HGRN, D_MODEL, HGRN_IN), D_MODEL ** -0.5),
        'hgrn_lower_bound': 1.0 + nrm(ks[7], (DEPTH, 2, MIX_W), 0.1),
        'hgrn_norm': 1.0 + nrm(ks[8], (N_HGRN, MIX_W), 0.02),
        'conv_w_in': nrm(ks[9], (N_CONV, D_MODEL, CONV_IN), D_MODEL ** -0.5),
        'conv_w': nrm(ks[10], (N_CONV, CONV_W, MIX_W), CONV_W ** -0.5),
        'mem_w_kv': nrm(ks[11], (DEPTH, D_MODEL, 2 * XATTN_W), D_MODEL ** -0.5),
        'w_o': nrm(ks[12], (DEPTH, D_MODEL, D_MODEL), BETA * D_MODEL ** -0.5),
        'ln_gain': 1.0 + nrm(ks[13], (DEPTH, 2, D_MODEL), 0.02),
        'ln_bias': nrm(ks[14], (DEPTH, 2, D_MODEL), 0.02),
        'ffn_w_up': nrm(ks[15], (DEPTH, D_MODEL, 2 * D_FF), D_MODEL ** -0.5),
        'ffn_conv': nrm(ks[16], (DEPTH, CONV_W, 2 * D_FF), CONV_W ** -0.5),
        'ffn_w_down': nrm(ks[17], (DEPTH, D_FF, D_MODEL), BETA * D_FF ** -0.5),
    }


def reference(x, mem, rel_bias, attn_w_in, attn_lambda, attn_subln, hgrn_w_in,
              hgrn_lower_bound, hgrn_norm, conv_w_in, conv_w, mem_w_kv, w_o,
              ln_gain, ln_bias, ffn_w_up, ffn_conv, ffn_w_down):
    for layer in range(DEPTH):
        kind, j = layer % N_MIXERS, layer // N_MIXERS
        if kind == 0:
            p = x @ attn_w_in[j]
            mixed = _diff_attention(p[..., :3 * MIX_W], attn_lambda[j], attn_subln[j], rel_bias, layer)
        elif kind == 1:
            p = x @ hgrn_w_in[j]
            mixed = _hgrn2(p[..., :5 * MIX_W], hgrn_lower_bound, hgrn_norm[j], layer)
        else:
            p = x @ conv_w_in[j]
            mixed = _short_conv(p[..., :3 * MIX_W], conv_w[j])
        recalled = _memory_attention(p[..., 3 * MIX_W if kind != 1 else 5 * MIX_W:], mem, mem_w_kv[layer])
        y = jnp.concatenate([mixed, recalled], axis=-1) @ w_o[layer]
        x = _layer_norm(ALPHA * x + y, ln_gain[layer, 0], ln_bias[layer, 0])
        f = _conv_ffn(x, ffn_w_up[layer], ffn_conv[layer], ffn_w_down[layer])
        x = _layer_norm(ALPHA * x + f, ln_gain[layer, 1], ln_bias[layer, 1])
    return x
```

```cpp
#define N_LAUNCHES 51
#include <hip/hip_runtime.h>
#include <hip/hip_cooperative_groups.h>
#include <cstdio>
namespace cg = cooperative_groups;

__device__ __forceinline__ int otid() { int t = threadIdx.x; asm volatile("" : "+v"(t)); return t; }
#ifndef PG8_AUX
#define PG8_AUX 0
#endif
namespace pg8 {
#define PG8_LAS __attribute__((address_space(3)))
typedef unsigned short bf16_t;
typedef short bf16x8 __attribute__((ext_vector_type(8)));
typedef float f32x4 __attribute__((ext_vector_type(4)));
typedef unsigned u32x4 __attribute__((ext_vector_type(4)));
constexpr int BM = 256, BK = 64, HALF = 128, HTB = HALF * BK * 2  , STAGE_BYTES = 8 * HTB, NXCD = 8, WGM = 8;

__host__ __device__ __forceinline__ int lds_byte(int r, int c) { const int st = (r >> 4) * 2 + (c >> 5), rr = r & 15, cc = c & 31, ob = rr * 64 + cc * 2; return st * 1024 + (ob ^ (((ob >> 9) & 1) << 5)); }
__host__ __device__ __forceinline__ void stage_rc(int b, int& R, int& C) { const int st = b / 1024, sb = b % 1024, swz = sb ^ (((sb >> 9) & 1) << 5); R = (st >> 1) * 16 + swz / 64; C = (st & 1) * 32 + (swz % 64) / 2; }
__host__ __device__ __forceinline__ int perm32(int rho) { const int n = rho >> 4, i = rho & 15; return 8 * (i >> 2) + 4 * n + (i & 3); }
struct Unit { int pm, pn; };
struct Gemm { const bf16_t* A; const bf16_t* Bt; int M, N, K; };
struct StaticOrder {
    int nM, nN, nwg, G, c;
    __host__ __device__ void init(int M, int N, int G_, int c_) { nM = M / BM; nN = N / BM; nwg = nM * nN; G = G_; c = c_; }
    __host__ __device__ bool next(int i, Unit& u) const {
        const long L = (long)i * G + c; if (L >= nwg) return false;
        int wgid = (int)L; { const int q = nwg / NXCD, r = nwg % NXCD, xcd = wgid % NXCD, off = wgid / NXCD; wgid = (xcd < r ? xcd * (q + 1) : r * (q + 1) + (xcd - r) * q) + off; }
        const int nig = WGM * nN, gid = wgid / nig, fm = gid * WGM, gsz = (nM - fm) < WGM ? (nM - fm) : WGM;
        u.pm = fm + ((wgid % nig) % gsz); u.pn = (wgid % nig) / gsz; return true;
    }
    __device__ __forceinline__ void a_ready(const Unit&) const {}
    __device__ __forceinline__ void done(const Unit&) const {}
};
typedef __bf16 pg8_bf2 __attribute__((ext_vector_type(2)));
typedef float pg8_f2 __attribute__((ext_vector_type(2)));
__device__ __forceinline__ unsigned cvt_pk_bf16(float lo, float hi) { pg8_f2 v; v.x = lo; v.y = hi; return __builtin_bit_cast(unsigned, __builtin_convertvector(v, pg8_bf2)); }
template <class Epi, class Sched, bool STAMP = false>
__device__ __forceinline__ void gemm_phase(PG8_LAS unsigned char* lds, const Gemm g, const Sched& S, const Epi& E, unsigned long long* stamps) {
    const int tid = otid(), wid = __builtin_amdgcn_readfirstlane(tid >> 6), lane = tid & 63, wr = wid >> 2, wc = wid & 3, fr = lane & 15, fq = lane >> 4;
    const int K = g.K, nt = K / BK;
    int ts_lo = 0, ts_hi = 0, nts = 0; const unsigned long long rt_entry = STAMP ? (unsigned long long)wall_clock64() : 0ull;
#define PG8_STAMP() do { if (STAMP && wid == 0 && nts < 64) { const unsigned long long _c = (unsigned long long)clock64(); \
        ts_lo = (lane == nts) ? (int)(unsigned)_c : ts_lo; ts_hi = (lane == nts) ? (int)(unsigned)(_c >> 32) : ts_hi; ++nts; } } while (0)
    PG8_STAMP();
    unsigned voffA[2], voffB[2];
#pragma unroll
    for (int i = 0; i < 2; ++i) { int R, C; stage_rc(tid * 16 + i * 8192, R, C); const int Rb = Epi::PERM ? ((R & ~31) + perm32(R & 31)) : R;
        voffA[i] = (unsigned)(R * K + C) * 2u; voffB[i] = (unsigned)(Rb * K + C) * 2u; }
    const size_t kstep = (size_t)(BK * 2);
    const size_t hstep = (size_t)HALF * K * 2;
    const size_t tstep = 2 * hstep;
    const unsigned ldsw = (unsigned)wid * 1024u;
    const int aoff = lds_byte(wr * 64 + fr, fq * 8), boff = lds_byte(wc * 32 + fr, fq * 8);
#define PG8_SA(b, h) (((b) * 2 + (h)) * HTB)
#define PG8_SB(b, h) ((4 + (b) * 2 + (h)) * HTB)
#define PG8_STAGE(bufoff, gbase, voff) do { _Pragma("unroll") for (int _i = 0; _i < 2; ++_i) \
        __builtin_amdgcn_global_load_lds((const unsigned*)((const char*)(gbase) + (voff)[_i]), (PG8_LAS unsigned*)(lds + (bufoff) + ldsw + _i * 8192), 16, 0, PG8_AUX); } while (0)
#define PG8_LDA(dst, b, h) do { _Pragma("unroll") for (int m = 0; m < 4; ++m) _Pragma("unroll") for (int k = 0; k < 2; ++k) dst[m][k] = *(const PG8_LAS bf16x8*)(lds + PG8_SA(b, h) + aoff + m * 2048 + k * 1024); } while (0)
#define PG8_LDB(dst, b, h) do { _Pragma("unroll") for (int n = 0; n < 2; ++n) _Pragma("unroll") for (int k = 0; k < 2; ++k) dst[n][k] = *(const PG8_LAS bf16x8*)(lds + PG8_SB(b, h) + boff + n * 2048 + k * 1024); } while (0)
#define PG8_MMA(ai, bj, At, Bt) do { __builtin_amdgcn_s_setprio(1); _Pragma("unroll") for (int m = 0; m < 4; ++m) _Pragma("unroll") for (int n = 0; n < 2; ++n) _Pragma("unroll") for (int k = 0; k < 2; ++k) \
        acc[ai][bj][m][n] = __builtin_amdgcn_mfma_f32_16x16x32_bf16(Bt[n][k], At[m][k], acc[ai][bj][m][n], 0, 0, 0); __builtin_amdgcn_s_setprio(0); } while (0)
#define PG8_WAIT_V(n) asm volatile("s_waitcnt vmcnt(" #n ")" ::: "memory")
#define PG8_WAIT_L(n) asm volatile("s_waitcnt lgkmcnt(" #n ")" ::: "memory")
#define PG8_BAR __builtin_amdgcn_s_barrier()
#define PG8_SCHED __builtin_amdgcn_sched_barrier(0)
    Unit cur, nxt; int ui = 0;
    if (!S.next(0, cur)) return;
    f32x4 acc[2][2][4][2];
#pragma unroll
    for (int a = 0; a < 2; ++a)
#pragma unroll
        for (int b = 0; b < 2; ++b)
#pragma unroll
            for (int m = 0; m < 4; ++m)
#pragma unroll
                for (int n = 0; n < 2; ++n) acc[a][b][m][n] = (f32x4){0.f, 0.f, 0.f, 0.f};
    bf16x8 At[4][2], B0[2][2], B1[2][2];
    const char* cA = (const char*)g.A + (size_t)cur.pm * tstep; const char* cB = (const char*)g.Bt + (size_t)cur.pn * tstep;
    S.a_ready(cur);
    PG8_STAGE(PG8_SB(0, 0), cB, voffB); PG8_STAGE(PG8_SA(0, 0), cA, voffA); PG8_STAGE(PG8_SB(0, 1), cB + hstep, voffB); PG8_STAGE(PG8_SA(0, 1), cA + hstep, voffA);
    if (wr == 1) PG8_BAR;
    PG8_WAIT_V(4); PG8_BAR;
    PG8_STAGE(PG8_SB(1, 0), cB + kstep, voffB); PG8_STAGE(PG8_SA(1, 0), cA + kstep, voffA); PG8_STAGE(PG8_SB(1, 1), cB + hstep + kstep, voffB);
    PG8_WAIT_V(6); PG8_BAR;
    PG8_STAMP();
    for (;;) {
        const bool has_next = S.next(ui + 1, nxt);
        const char* nA = has_next ? (const char*)g.A + (size_t)nxt.pm * tstep : cA; const char* nB = has_next ? (const char*)g.Bt + (size_t)nxt.pn * tstep : cB;
        for (int t = 0; t < nt; t += 2) {
            const bool last = (t == nt - 2);
            const char* a1 = cA + (size_t)(t + 1) * kstep;
            const char* a2 = last ? nA : cA + (size_t)(t + 2) * kstep; const char* b2 = last ? nB : cB + (size_t)(t + 2) * kstep;
            const char* a3 = a2 + kstep; const char* b3 = b2 + kstep;
            if (last && has_next) S.a_ready(nxt);
            PG8_LDB(B0, 0, 0); PG8_SCHED; PG8_LDA(At, 0, 0); PG8_STAGE(PG8_SA(1, 1), a1 + hstep, voffA);
            PG8_WAIT_L(8); PG8_BAR; PG8_WAIT_L(0); PG8_MMA(0, 0, At, B0); PG8_BAR; PG8_SCHED;
            PG8_LDB(B1, 0, 1); PG8_STAGE(PG8_SB(0, 0), b2, voffB);
            PG8_BAR; PG8_WAIT_L(0); PG8_MMA(0, 1, At, B1); PG8_BAR;
            PG8_LDA(At, 0, 1); PG8_STAGE(PG8_SA(0, 0), a2, voffA);
            PG8_BAR; PG8_WAIT_L(0); PG8_MMA(1, 0, At, B0); PG8_BAR; PG8_SCHED;
            PG8_STAGE(PG8_SB(0, 1), b2 + hstep, voffB);
            PG8_WAIT_V(6); PG8_BAR; PG8_MMA(1, 1, At, B1); PG8_BAR;
            PG8_LDB(B0, 1, 0); PG8_SCHED; PG8_LDA(At, 1, 0); PG8_STAGE(PG8_SA(0, 1), a2 + hstep, voffA);
            PG8_WAIT_L(8); PG8_BAR; PG8_WAIT_L(0); PG8_MMA(0, 0, At, B0); PG8_BAR; PG8_SCHED;
            PG8_LDB(B1, 1, 1); PG8_STAGE(PG8_SB(1, 0), b3, voffB);
            PG8_BAR; PG8_WAIT_L(0); PG8_MMA(0, 1, At, B1); PG8_BAR;
            PG8_LDA(At, 1, 1); PG8_STAGE(PG8_SA(1, 0), a3, voffA);
            PG8_BAR; PG8_WAIT_L(0); PG8_MMA(1, 0, At, B0); PG8_BAR; PG8_SCHED;
            PG8_STAGE(PG8_SB(1, 1), b3 + hstep, voffB);
            PG8_WAIT_V(6); PG8_BAR; PG8_MMA(1, 1, At, B1); PG8_BAR;
        }
        PG8_STAMP();
        if constexpr (!Epi::AFTER_DRAIN) { E(acc, cur, wr, wc, fr, fq); S.done(cur); }
        PG8_STAMP();
        if (!has_next) break;
#pragma unroll
        for (int a = 0; a < 2; ++a)
#pragma unroll
            for (int b = 0; b < 2; ++b)
#pragma unroll
                for (int m = 0; m < 4; ++m)
#pragma unroll
                    for (int n = 0; n < 2; ++n) acc[a][b][m][n] = (f32x4){0.f, 0.f, 0.f, 0.f};
        cur = nxt; cA = nA; cB = nB; ++ui;
    }
    PG8_WAIT_V(0);
    if (wr == 0) PG8_BAR;
    PG8_BAR;
    if constexpr (Epi::AFTER_DRAIN) { E.fused(acc, cur, wr, wc, fr, fq, lds, wid, lane); S.done(cur); }
    PG8_STAMP();
    if (STAMP && wid == 0) { stamps[lane] = lane < nts ? (((unsigned long long)(unsigned)ts_hi << 32) | (unsigned)ts_lo) : 0ull;
        if (lane == 62) stamps[62] = rt_entry; if (lane == 63) stamps[63] = (unsigned long long)wall_clock64(); }
#undef PG8_STAMP
#undef PG8_SA
#undef PG8_SB
#undef PG8_STAGE
#undef PG8_LDA
#undef PG8_LDB
#undef PG8_MMA
#undef PG8_WAIT_V
#undef PG8_WAIT_L
#undef PG8_BAR
#undef PG8_SCHED
}
}

using pg8::bf16_t; using pg8::bf16x8; using pg8::f32x4; using pg8::u32x4; using pg8::cvt_pk_bf16;
#define LAS PG8_LAS
typedef unsigned u32x2 __attribute__((ext_vector_type(2)));

constexpr int D = 1024, NTOK = 32768, SEQ = 8192, MIXW = 768, DFF = 2816;
constexpr float ALPHA = 1.6817928305074290f, LN_EPS = 1e-5f, LOG2E = 1.4426950408889634f;
constexpr size_t MiB = 1048576;
constexpr size_t WS_WIN = 0, WS_WO = 8 * MiB, WS_WUP = 10 * MiB, WS_WDN = 21 * MiB, WS_WKV = 27 * MiB, WS_MEMB = 31 * MiB, WS_KVM = 33 * MiB,
                 WS_ELAST = 37 * MiB, WS_XB = 40 * MiB, WS_BIG = 104 * MiB, WS_OB = 424 * MiB, WS_END = 472 * MiB;
constexpr size_t BIG_MIX = 256 * MiB, BIG_U = 176 * MiB;
constexpr int LDS_BYTES = 131072;

struct Params {
    const float *x, *mem, *rel_bias, *attn_w_in, *attn_lambda, *attn_subln, *hgrn_w_in, *hgrn_lb, *hgrn_norm, *conv_w_in, *conv_w, *mem_w_kv, *w_o,
                *ln_gain, *ln_bias, *ffn_w_up, *ffn_conv, *ffn_w_down;
    float* out; unsigned char* ws;
};

__device__ __forceinline__ float bf2f(unsigned short h) { return __uint_as_float(((unsigned)h) << 16); }
__device__ __forceinline__ float bflo(unsigned w) { return __uint_as_float(w << 16); }
__device__ __forceinline__ float bfhi(unsigned w) { return __uint_as_float(w & 0xffff0000u); }
__device__ __forceinline__ float fast_exp2(float x) { return __builtin_amdgcn_exp2f(x); }
__device__ __forceinline__ float sigmoidf_(float x) { return 1.0f / (1.0f + __expf(-x)); }
__device__ __forceinline__ float siluf_(float x) { return x / (1.0f + __expf(-x)); }

__device__ __forceinline__ void cvt_tile(const float* src, int ldsrc, int k0, int c0, bf16_t* dst, int lddst, int r0, float scale, LAS float* scr) {
    const int tid = otid();
    { const int n = tid & 63, kk = tid >> 6;
#pragma unroll
      for (int i = 0; i < 8; ++i) scr[(kk + 8 * i) * 65 + n] = src[(size_t)(k0 + kk + 8 * i) * ldsrc + c0 + n] * scale; }
    __syncthreads();
    { const int kp = tid & 31, nn = tid >> 5;
#pragma unroll
      for (int i = 0; i < 4; ++i) { const int n = nn + 16 * i;
          *(unsigned*)(dst + (size_t)(r0 + n) * lddst + k0 + 2 * kp) = cvt_pk_bf16(scr[(2 * kp) * 65 + n], scr[(2 * kp + 1) * 65 + n]); } }
    __syncthreads();
}
__device__ __forceinline__ void convert_layer(const Params& P, int layer, LAS unsigned char* lds) {
    LAS float* scr = (LAS float*)lds;
#ifdef DBG_KIND1
    const int kind = 1, jj = 0;
#else
    const int kind = layer % 3, jj = layer / 3;
#endif
    const int NIN = kind == 1 ? 4096 : 2560;
    const float* win = kind == 0 ? P.attn_w_in + (size_t)jj * D * 2560 : (kind == 1 ? P.hgrn_w_in + (size_t)jj * D * 4096 : P.conv_w_in + (size_t)jj * D * 2560);
#ifdef DBG_WALT
    bf16_t* Wt_in = (bf16_t*)(P.ws + (layer == 1 ? WS_OB : WS_WIN));
#else
    bf16_t* Wt_in = (bf16_t*)(P.ws + WS_WIN);
#endif
    bf16_t* Wt_o = (bf16_t*)(P.ws + WS_WO); bf16_t* Wt_up = (bf16_t*)(P.ws + WS_WUP); bf16_t* Wt_dn = (bf16_t*)(P.ws + WS_WDN);
    const int T_IN = (NIN / 64) * 16, T_O = 256, T_UP = 88 * 16, T_DN = 16 * 44, T_ALL = T_IN + T_O + T_UP + T_DN;
    for (int it = blockIdx.x; it < T_ALL; it += gridDim.x) {
        int r = it;
        if (r < T_IN) { const int nt = r >> 4, kt = r & 15; const int c0 = nt * 64;
            const bool qcol = (kind == 0 && c0 < MIXW) || (c0 >= NIN - 256);
            cvt_tile(win, NIN, kt * 64, c0, Wt_in, D, c0, qcol ? 0.125f * LOG2E : 1.0f, scr); continue; }
        r -= T_IN;
        if (r < T_O) { const int nt = r >> 4, kt = r & 15; cvt_tile(P.w_o + (size_t)layer * D * D, D, kt * 64, nt * 64, Wt_o, D, nt * 64, 1.0f, scr); continue; }
        r -= T_O;
        if (r < T_UP) { const int nt = r >> 4, kt = r & 15; const int j = nt >> 2, q = nt & 3; const int c0 = q < 2 ? j * 128 + q * 64 : DFF + j * 128 + (q - 2) * 64;
            cvt_tile(P.ffn_w_up + (size_t)layer * D * 2 * DFF, 2 * DFF, kt * 64, c0, Wt_up, D, nt * 64, 1.0f, scr); continue; }
        r -= T_UP;
        { const int nt = r / 44, kt = r % 44; cvt_tile(P.ffn_w_down + (size_t)layer * DFF * D, D, kt * 64, nt * 64, Wt_dn, DFF, nt * 64, 1.0f, scr); }
    }
}
__device__ __forceinline__ void convert_prologue(const Params& P, LAS unsigned char* lds) {
    LAS float* scr = (LAS float*)lds;
    bf16_t* Wt_kv = (bf16_t*)(P.ws + WS_WKV);
    for (int it = blockIdx.x; it < 512; it += gridDim.x) { const int l = it >> 7, r = it & 127, nt = r >> 4, kt = r & 15;
        cvt_tile(P.mem_w_kv + (size_t)l * D * 512, 512, kt * 64, nt * 64, Wt_kv, D, l * 512 + nt * 64, 1.0f, scr); }
    const size_t gt = (size_t)blockIdx.x * 512 + otid(), gs = (size_t)gridDim.x * 512;
    { const f32x4* s = (const f32x4*)P.x; u32x2* d = (u32x2*)(P.ws + WS_XB);
      for (size_t i = gt; i < (size_t)NTOK * D / 4; i += gs) { const f32x4 v = s[i]; u32x2 o; o.x = cvt_pk_bf16(v.x, v.y); o.y = cvt_pk_bf16(v.z, v.w); d[i] = o; } }
    { const f32x4* s = (const f32x4*)P.mem; u32x2* d = (u32x2*)(P.ws + WS_MEMB);
      for (size_t i = gt; i < (size_t)1024 * D / 4; i += gs) { const f32x4 v = s[i]; u32x2 o; o.x = cvt_pk_bf16(v.x, v.y); o.y = cvt_pk_bf16(v.z, v.w); d[i] = o; } }
}

struct EpiBf16P {
    static constexpr bool PERM = true, AFTER_DRAIN = false;
    bf16_t* O; int ldc;
    __device__ __forceinline__ void operator()(const f32x4 (&acc)[2][2][4][2], const pg8::Unit& u, int wr, int wc, int fr, int fq) const {
        const int row0 = u.pm * 256 + wr * 64 + fr, col0 = u.pn * 256 + wc * 32 + 8 * fq;
#pragma unroll
        for (int ai = 0; ai < 2; ++ai)
#pragma unroll
            for (int m = 0; m < 4; ++m) { bf16_t* rowp = O + (size_t)(row0 + ai * 128 + m * 16) * ldc + col0;
#pragma unroll
                for (int bj = 0; bj < 2; ++bj) { const f32x4 v0 = acc[ai][bj][m][0], v1 = acc[ai][bj][m][1];
                    u32x4 w; w.x = cvt_pk_bf16(v0[0], v0[1]); w.y = cvt_pk_bf16(v0[2], v0[3]); w.z = cvt_pk_bf16(v1[0], v1[1]); w.w = cvt_pk_bf16(v1[2], v1[3]);
                    *(u32x4*)(rowp + bj * 128) = w; } }
    }
};
struct EpiResid {
    static constexpr bool PERM = false, AFTER_DRAIN = false;
    float* io; const float* xin;
    __device__ __forceinline__ void operator()(const f32x4 (&acc)[2][2][4][2], const pg8::Unit& u, int wr, int wc, int fr, int fq) const {
        const int row0 = u.pm * 256 + wr * 64 + fr, col0 = u.pn * 256 + wc * 32 + 4 * fq;
#pragma unroll
        for (int ai = 0; ai < 2; ++ai)
#pragma unroll
            for (int m = 0; m < 4; ++m) { const size_t ro = (size_t)(row0 + ai * 128 + m * 16) * D + col0;
#pragma unroll
                for (int bj = 0; bj < 2; ++bj)
#pragma unroll
                    for (int n = 0; n < 2; ++n) { const f32x4 xv = *(const f32x4*)(xin + ro + bj * 128 + n * 16);
                        *(f32x4*)(io + ro + bj * 128 + n * 16) = xv * ALPHA + acc[ai][bj][m][n]; } }
    }
};
template <class Epi>
__device__ __forceinline__ void run_gemm(LAS unsigned char* lds, const bf16_t* A, const bf16_t* Bt, int M, int N, int K, const Epi& E) {
    pg8::StaticOrder S; S.init(M, N, (int)gridDim.x, (int)blockIdx.x);
    pg8::Gemm g; g.A = A; g.Bt = Bt; g.M = M; g.N = N; g.K = K;
    pg8::gemm_phase<Epi, pg8::StaticOrder, false>(lds, g, S, E, nullptr);
    __syncthreads();
}

__device__ __forceinline__ float wave_sum(float v) {
#pragma unroll
    for (int o = 32; o >= 1; o >>= 1) v += __shfl_xor(v, o);
    return v;
}
__device__ __forceinline__ void ln_phase(float* io, bf16_t* xb, const float* gain, const float* bias) {
    const int lane = otid() & 63, wid = otid() >> 6;
    f32x4 gv[4], bv[4];
#pragma unroll
    for (int j = 0; j < 4; ++j) { gv[j] = ((const f32x4*)gain)[lane + 64 * j]; bv[j] = ((const f32x4*)bias)[lane + 64 * j]; }
#ifdef LN_AFF
    for (int rr = 0; rr < 16; ++rr) { const int row = 4096 * (blockIdx.x & 7) + (blockIdx.x >> 3) * 128 + wid * 16 + rr;
#else
    for (int row = blockIdx.x * 8 + wid; row < NTOK; row += gridDim.x * 8) {
#endif
        f32x4* xr = (f32x4*)(io + (size_t)row * D) + lane;
        f32x4 v[4]; float s = 0.f;
#pragma unroll
        for (int j = 0; j < 4; ++j) { v[j] = xr[64 * j]; s += (v[j].x + v[j].y) + (v[j].z + v[j].w); }
        const float mean = wave_sum(s) * (1.f / D); float s2 = 0.f;
#pragma unroll
        for (int j = 0; j < 4; ++j) { v[j] = v[j] - mean; s2 += (v[j].x * v[j].x + v[j].y * v[j].y) + (v[j].z * v[j].z + v[j].w * v[j].w); }
        const float rstd = 1.0f / sqrtf(wave_sum(s2) * (1.f / D) + LN_EPS);
        u32x2* o8 = (u32x2*)(xb + (size_t)row * D) + lane;
#pragma unroll
        for (int j = 0; j < 4; ++j) { const f32x4 y = v[j] * rstd * gv[j] + bv[j]; xr[64 * j] = y;
            u32x2 o; o.x = cvt_pk_bf16(y.x, y.y); o.y = cvt_pk_bf16(y.z, y.w); o8[64 * j] = o; }
    }
}

__device__ __forceinline__ void unpack8(const u32x4 w, float (&f)[8]) {
    f[0] = bflo(w.x); f[1] = bfhi(w.x); f[2] = bflo(w.y); f[3] = bfhi(w.y); f[4] = bflo(w.z); f[5] = bfhi(w.z); f[6] = bflo(w.w); f[7] = bfhi(w.w);
}
__device__ __forceinline__ void gate_phase(const bf16_t* u, int ldu, int tile0, int ntile, bf16_t* g, const float* cw  ) {
    const int tid = otid();
    const int combo = tid & 127, sub = tid >> 7;
    const int jj = combo >> 4, cg = combo & 15;
    if (jj >= ntile) return;
    const int ca = (tile0 + jj) * 128 + cg * 8, cv = DFF + ca;
    float wa[3][8], wv[3][8];
#pragma unroll
    for (int t = 0; t < 3; ++t)
#pragma unroll
        for (int i = 0; i < 8; ++i) { wa[t][i] = cw[(size_t)t * 2 * DFF + ca + i]; wv[t][i] = cw[(size_t)t * 2 * DFF + cv + i]; }
    const u32x4 zero4 = (u32x4){0u, 0u, 0u, 0u};
    for (int strip = blockIdx.x; strip < NTOK / 64; strip += gridDim.x) {
        const int t0 = strip * 64 + sub * 16;
        const bf16_t* ua = u + (size_t)t0 * ldu + jj * 256 + cg * 8;
        u32x4 pa, pv, ca4, cv4, na, nv;
        if ((t0 & (SEQ - 1)) == 0) { pa = zero4; pv = zero4; } else { pa = *(const u32x4*)(ua - ldu); pv = *(const u32x4*)(ua - ldu + 128); }
        ca4 = *(const u32x4*)ua; cv4 = *(const u32x4*)(ua + 128);
#pragma unroll 2
        for (int t = 0; t < 16; ++t) {
            const int tt = t0 + t;
            if ((tt & (SEQ - 1)) == SEQ - 1) { na = zero4; nv = zero4; } else { na = *(const u32x4*)(ua + (size_t)(t + 1) * ldu); nv = *(const u32x4*)(ua + (size_t)(t + 1) * ldu + 128); }
            float fpa[8], fca[8], fna[8], fpv[8], fcv[8], fnv[8], o[8];
            unpack8(pa, fpa); unpack8(ca4, fca); unpack8(na, fna); unpack8(pv, fpv); unpack8(cv4, fcv); unpack8(nv, fnv);
#pragma unroll
            for (int i = 0; i < 8; ++i) { const float ha = wa[0][i] * fpa[i] + wa[1][i] * fca[i] + wa[2][i] * fna[i];
                const float hv = wv[0][i] * fpv[i] + wv[1][i] * fcv[i] + wv[2][i] * fnv[i]; o[i] = siluf_(ha) * hv; }
            u32x4 w; w.x = cvt_pk_bf16(o[0], o[1]); w.y = cvt_pk_bf16(o[2], o[3]); w.z = cvt_pk_bf16(o[4], o[5]); w.w = cvt_pk_bf16(o[6], o[7]);
            *(u32x4*)(g + (size_t)tt * DFF + ca) = w;
            pa = ca4; pv = cv4; ca4 = na; cv4 = nv;
        }
    }
}

__device__ __forceinline__ void shortconv_phase(const bf16_t* p, int ldp, bf16_t* mix, const float* cw  ) {
    const int tid = otid();
    if (tid >= 384) return;
    const int cg = tid % 96, sub = tid / 96, c = cg * 8;
    float w[3][8];
#pragma unroll
    for (int t = 0; t < 3; ++t)
#pragma unroll
        for (int i = 0; i < 8; ++i) w[t][i] = cw[t * MIXW + c + i];
    for (int strip = blockIdx.x; strip < NTOK / 64; strip += gridDim.x) {
        const int t0 = strip * 64 + sub * 16;
        const bf16_t* pr = p + (size_t)t0 * ldp + c;
        float pp[8], pc[8], pn[8], a[8], b[8];
        if ((t0 & (SEQ - 1)) == 0) {
#pragma unroll
            for (int i = 0; i < 8; ++i) pp[i] = 0.f;
        } else { unpack8(*(const u32x4*)(pr - ldp + MIXW), a); unpack8(*(const u32x4*)(pr - ldp + 2 * MIXW), b);
#pragma unroll
            for (int i = 0; i < 8; ++i) pp[i] = a[i] * b[i]; }
        unpack8(*(const u32x4*)(pr + MIXW), a); unpack8(*(const u32x4*)(pr + 2 * MIXW), b);
#pragma unroll
        for (int i = 0; i < 8; ++i) pc[i] = a[i] * b[i];
#pragma unroll 2
        for (int t = 0; t < 16; ++t) {
            const int tt = t0 + t; const bf16_t* r = pr + (size_t)t * ldp;
            if ((tt & (SEQ - 1)) == SEQ - 1) {
#pragma unroll
                for (int i = 0; i < 8; ++i) pn[i] = 0.f;
            } else { unpack8(*(const u32x4*)(r + ldp + MIXW), a); unpack8(*(const u32x4*)(r + ldp + 2 * MIXW), b);
#pragma unroll
                for (int i = 0; i < 8; ++i) pn[i] = a[i] * b[i]; }
            float gb[8], o[8]; unpack8(*(const u32x4*)r, gb);
#pragma unroll
            for (int i = 0; i < 8; ++i) o[i] = gb[i] * (w[0][i] * pp[i] + w[1][i] * pc[i] + w[2][i] * pn[i]);
            u32x4 ow; ow.x = cvt_pk_bf16(o[0], o[1]); ow.y = cvt_pk_bf16(o[2], o[3]); ow.z = cvt_pk_bf16(o[4], o[5]); ow.w = cvt_pk_bf16(o[6], o[7]);
            *(u32x4*)(mix + (size_t)tt * D + c) = ow;
#pragma unroll
            for (int i = 0; i < 8; ++i) { pp[i] = pc[i]; pc[i] = pn[i]; }
        }
    }
}

__device__ __forceinline__ bf16x8 mk8(u32x2 lo, u32x2 hi) { u32x4 t; t.x = lo.x; t.y = lo.y; t.z = hi.x; t.w = hi.y; return __builtin_bit_cast(bf16x8, t); }
__device__ __forceinline__ f32x4 mfma16(bf16x8 a, bf16x8 b, f32x4 c) { return __builtin_amdgcn_mfma_f32_16x16x32_bf16(a, b, c, 0, 0, 0); }

__device__ __forceinline__ int t5_bucket(int rel) {
    const int n = rel < 0 ? -rel : rel; int b;
    if (n < 8) b = n; else { int lg = 2 + (31 - __clz(n * n)); b = lg > 15 ? 15 : lg; }
    return b + (rel > 0 ? 16 : 0);
}
template <int MODE>
__device__ __forceinline__ void flash_item(LAS unsigned char* lds, const bf16_t* Qp, int ldq, const bf16_t* Kp, int ldk, const bf16_t* Vp, int ldv,
                                           int nkeys, int q0, const float* gbias, bf16_t* Op, float lam, const float* subln, float outscale) {
    constexpr int EB = MODE ? 8 : 4, KROWB = MODE ? 256 : 128, KPITCH = KROWB + 16, VPITCH = 136, KBYTES = 64 * KPITCH, BUFB = KBYTES + EB * 16 * VPITCH;
    constexpr int KCH = KROWB / 16, NKL = 64 * KCH / 512;
    const int tid = otid(), lane = tid & 63, wid = __builtin_amdgcn_readfirstlane(tid >> 6), l15 = lane & 15, quad = lane >> 4;
    const int sub = MODE ? (wid >> 2) : 0, qrow0 = MODE ? (wid & 3) * 32 : wid * 32;
    bf16x8 Qf[2][2];
#pragma unroll
    for (int qt = 0; qt < 2; ++qt)
#pragma unroll
        for (int ks = 0; ks < 2; ++ks) Qf[qt][ks] = *(const bf16x8*)(Qp + (size_t)(qrow0 + qt * 16 + l15) * ldq + sub * 64 + ks * 32 + quad * 8);
    f32x4 O[2][EB];
#pragma unroll
    for (int qt = 0; qt < 2; ++qt)
#pragma unroll
        for (int eb = 0; eb < EB; ++eb) O[qt][eb] = (f32x4){0.f, 0.f, 0.f, 0.f};
    float lrun[2] = {0.f, 0.f}, mref[2];
    u32x4 kreg[NKL], vreg[2];
    const int veg = (EB == 8) ? ((wid & 3) * 4 + (lane & 3)) : ((wid & 1) * 4 + (lane & 3));
    const int vpair = (EB == 8) ? ((wid >> 2) * 16 + (lane >> 2)) : ((wid >> 1) * 16 + (lane >> 2));
    const bool vact = (EB == 8) || (wid < 4);
    auto gload = [&](int k0) {
#pragma unroll
        for (int i = 0; i < NKL; ++i) { const int c = tid + i * 512, chunk = c % KCH, key = c / KCH;
            kreg[i] = *(const u32x4*)(Kp + (size_t)(k0 + key) * ldk + chunk * 8); }
        if (vact) { vreg[0] = *(const u32x4*)(Vp + (size_t)(k0 + 2 * vpair) * ldv + veg * 8); vreg[1] = *(const u32x4*)(Vp + (size_t)(k0 + 2 * vpair + 1) * ldv + veg * 8); }
    };
    auto lstore = [&](int buf) {
        LAS unsigned char* kb = lds + buf * BUFB; LAS unsigned char* vb = kb + KBYTES;
#pragma unroll
        for (int i = 0; i < NKL; ++i) { const int c = tid + i * 512, chunk = c % KCH, key = c / KCH;
            *(LAS u32x4*)(kb + key * KPITCH + chunk * 16) = kreg[i]; }
        if (vact) {
            const unsigned a[4] = {vreg[0].x, vreg[0].y, vreg[0].z, vreg[0].w}, b[4] = {vreg[1].x, vreg[1].y, vreg[1].z, vreg[1].w};
#pragma unroll
            for (int i = 0; i < 4; ++i) {
                *(LAS unsigned*)(vb + (veg * 8 + 2 * i) * VPITCH + vpair * 4) = (a[i] & 0xffffu) | (b[i] << 16);
                *(LAS unsigned*)(vb + (veg * 8 + 2 * i + 1) * VPITCH + vpair * 4) = (a[i] >> 16) | (b[i] & 0xffff0000u);
            }
        }
    };
    const int nt = nkeys / 64;
    gload(0); lstore(0); __syncthreads();
    const int qlo = q0 + qrow0;
    {
        float mx0 = -INFINITY, mx1 = -INFINITY;
#pragma unroll
        for (int kb = 0; kb < 4; ++kb) {
            f32x4 S0 = (f32x4){0.f, 0.f, 0.f, 0.f}, S1 = (f32x4){0.f, 0.f, 0.f, 0.f};
#pragma unroll
            for (int ks = 0; ks < 2; ++ks) {
                const bf16x8 a = *(const LAS bf16x8*)(lds + (kb * 16 + l15) * KPITCH + sub * 128 + ks * 64 + quad * 16);
                S0 = mfma16(a, Qf[0][ks], S0); S1 = mfma16(a, Qf[1][ks], S1);
            }
            mx0 = fmaxf(mx0, fmaxf(fmaxf(S0[0], S0[1]), fmaxf(S0[2], S0[3]))); mx1 = fmaxf(mx1, fmaxf(fmaxf(S1[0], S1[1]), fmaxf(S1[2], S1[3])));
        }
        mx0 = fmaxf(mx0, __shfl_xor(mx0, 16)); mx0 = fmaxf(mx0, __shfl_xor(mx0, 32)); mx1 = fmaxf(mx1, __shfl_xor(mx1, 16)); mx1 = fmaxf(mx1, __shfl_xor(mx1, 32));
        mref[0] = mx0; mref[1] = mx1;
    }
    for (int t = 0; t < nt; ++t) {
        const int k0 = t * 64;
        LAS unsigned char* kbuf = lds + (t & 1) * BUFB; LAS unsigned char* vbuf = kbuf + KBYTES;
        if (t + 1 < nt) gload(k0 + 64);
        bf16x8 Pf[2][2];
        bool bnear = false; float bconst = 0.f;
#ifndef T_NOBIAS
#ifdef T_NONEAR
        if (MODE) { if (k0 >= qlo) bconst = btab[511]; else bconst = btab[0]; }
#else
        if (MODE) { if (k0 - (qlo + 31) >= 91) bconst = gbias[31 * 6] * LOG2E; else if (qlo - (k0 + 63) >= 91) bconst = gbias[15 * 6] * LOG2E; else bnear = true; }
#endif
#endif
        const float sh0 = bconst - mref[0], sh1 = bconst - mref[1];
#pragma unroll
        for (int g = 0; g < 2; ++g) {
            u32x4 w0, w1;
#pragma unroll
            for (int hb = 0; hb < 2; ++hb) {
                const int kb = 2 * g + hb;
                f32x4 S0 = (f32x4){sh0, sh0, sh0, sh0}, S1 = (f32x4){sh1, sh1, sh1, sh1};
                if (MODE && bnear) {
                    const int r0 = k0 + kb * 16 + quad * 4 - (qlo + l15);
#pragma unroll
                    for (int j = 0; j < 4; ++j) { S0[j] += gbias[t5_bucket(r0 + j) * 6] * LOG2E; S1[j] += gbias[t5_bucket(r0 + j - 16) * 6] * LOG2E; }
                }
#pragma unroll
                for (int ks = 0; ks < 2; ++ks) {
                    const bf16x8 a = *(const LAS bf16x8*)(kbuf + (kb * 16 + l15) * KPITCH + sub * 128 + ks * 64 + quad * 16);
                    S0 = mfma16(a, Qf[0][ks], S0); S1 = mfma16(a, Qf[1][ks], S1);
                }
#pragma unroll
                for (int j = 0; j < 4; ++j) { S0[j] = fast_exp2(S0[j]); S1[j] = fast_exp2(S1[j]); }
                lrun[0] += (S0[0] + S0[1]) + (S0[2] + S0[3]); lrun[1] += (S1[0] + S1[1]) + (S1[2] + S1[3]);
                if (hb == 0) { w0.x = cvt_pk_bf16(S0[0], S0[1]); w0.y = cvt_pk_bf16(S0[2], S0[3]); w1.x = cvt_pk_bf16(S1[0], S1[1]); w1.y = cvt_pk_bf16(S1[2], S1[3]); }
                else         { w0.z = cvt_pk_bf16(S0[0], S0[1]); w0.w = cvt_pk_bf16(S0[2], S0[3]); w1.z = cvt_pk_bf16(S1[0], S1[1]); w1.w = cvt_pk_bf16(S1[2], S1[3]); }
            }
            Pf[0][g] = __builtin_bit_cast(bf16x8, w0); Pf[1][g] = __builtin_bit_cast(bf16x8, w1);
        }
#pragma unroll
        for (int g = 0; g < 2; ++g)
#pragma unroll
            for (int eb = 0; eb < EB; ++eb) {
                const LAS unsigned char* vp = vbuf + (eb * 16 + l15) * VPITCH + (32 * g + 4 * quad) * 2;
                const bf16x8 a = mk8(*(const LAS u32x2*)vp, *(const LAS u32x2*)(vp + 32));
                O[0][eb] = mfma16(a, Pf[0][g], O[0][eb]); O[1][eb] = mfma16(a, Pf[1][g], O[1][eb]);
            }
        if (t + 1 < nt) lstore((t + 1) & 1);
        __syncthreads();
    }
    float inv[2];
#pragma unroll
    for (int qt = 0; qt < 2; ++qt) { float l = lrun[qt]; l += __shfl_xor(l, 16); l += __shfl_xor(l, 32); inv[qt] = 1.0f / l; }
    if (MODE == 0) {
#pragma unroll
        for (int qt = 0; qt < 2; ++qt) { bf16_t* orow = Op + (size_t)(qrow0 + qt * 16 + l15) * D + quad * 4;
#pragma unroll
            for (int eb = 0; eb < EB; ++eb) { const f32x4 y = O[qt][eb] * inv[qt];
                u32x2 w; w.x = cvt_pk_bf16(y.x, y.y); w.y = cvt_pk_bf16(y.z, y.w); *(u32x2*)(orow + eb * 16) = w; } }
    } else {
        LAS f32x4* X = (LAS f32x4*)lds + (size_t)(wid & 3) * (2 * EB * 64) + lane;
        if (sub == 1) {
#pragma unroll
            for (int qt = 0; qt < 2; ++qt)
#pragma unroll
                for (int eb = 0; eb < EB; ++eb) X[(qt * EB + eb) * 64] = O[qt][eb] * (lam * inv[qt]);
        }
        __syncthreads();
        if (sub == 0) {
#pragma unroll
            for (int qt = 0; qt < 2; ++qt) {
                f32x4 dv[EB]; float ss = 0.f;
#pragma unroll
#ifdef T_NOX
                for (int eb = 0; eb < EB; ++eb) { dv[eb] = O[qt][eb] * inv[qt];
#else
                for (int eb = 0; eb < EB; ++eb) { dv[eb] = O[qt][eb] * inv[qt] - X[(qt * EB + eb) * 64];
#endif
                    ss += (dv[eb].x * dv[eb].x + dv[eb].y * dv[eb].y) + (dv[eb].z * dv[eb].z + dv[eb].w * dv[eb].w); }
                ss += __shfl_xor(ss, 16); ss += __shfl_xor(ss, 32);
                const float r = outscale / sqrtf(ss * (1.0f / (EB * 16)) + LN_EPS);
                bf16_t* orow = Op + (size_t)(qrow0 + qt * 16 + l15) * D + quad * 4;
#pragma unroll
                for (int eb = 0; eb < EB; ++eb) { const f32x4 gsl = *(const f32x4*)(subln + eb * 16 + quad * 4); const f32x4 y = dv[eb] * r * gsl;
                    u32x2 w; w.x = cvt_pk_bf16(y.x, y.y); w.y = cvt_pk_bf16(y.z, y.w); *(u32x2*)(orow + eb * 16) = w; }
            }
        }
        __syncthreads();
    }
}

__device__ __forceinline__ void diffattn_phase(const Params& P, LAS unsigned char* lds, const bf16_t* p, bf16_t* mix, int layer) {
    const int jj = layer / 3;
    const float* lp = P.attn_lambda + jj * 256;
    float s01 = 0.f, s23 = 0.f;
    for (int i = 0; i < 64; ++i) { s01 += lp[i] * lp[64 + i]; s23 += lp[128 + i] * lp[192 + i]; }
    const float lam_init = 0.8f - 0.6f * expf(-0.3f * (float)layer);
    const float lam = expf(s01) - expf(s23) + lam_init;
    for (int item = blockIdx.x; item < 4 * 6 * 64; item += gridDim.x) {
        const int bh = item >> 6, qb = item & 63, b = bh / 6, h = bh % 6;
        const size_t tok0 = (size_t)b * SEQ + qb * 128;
        flash_item<1>(lds, p + tok0 * 2560 + h * 128, 2560, p + (size_t)b * SEQ * 2560 + MIXW + h * 128, 2560, p + (size_t)b * SEQ * 2560 + 2 * MIXW + h * 128, 2560,
                      SEQ, qb * 128, P.rel_bias + h, mix + tok0 * D + h * 128, lam, P.attn_subln + jj * 128, 1.0f - lam_init);
    }
}
__device__ __forceinline__ void memattn_phase(const Params& P, LAS unsigned char* lds, const bf16_t* p, int ldp, int xq0, bf16_t* mix, int layer) {
    const bf16_t* kvm = (const bf16_t*)(P.ws + WS_KVM);
    for (int item = blockIdx.x; item < 128 * 4; item += gridDim.x) {
        const int h = item & 3, qb = item >> 2; const size_t tok0 = (size_t)qb * 256; const int b = qb >> 5;
        const bf16_t* kp = kvm + (size_t)b * 256 * 2048 + layer * 512 + h * 64;
        flash_item<0>(lds, p + tok0 * ldp + xq0 + h * 64, ldp, kp, 2048, kp + 256, 2048, 256, 0, nullptr, mix + tok0 * D + MIXW + h * 64, 0.f, nullptr, 1.0f);
    }
}

__device__ __forceinline__ void hgrn_prep(const Params& P, bf16_t* p, bf16_t* QF, float* elast, int layer) {
    const size_t total = (size_t)4 * 128 * 384;
    for (size_t it = (size_t)blockIdx.x * 512 + otid(); it < total; it += (size_t)gridDim.x * 512) {
        const int cp = (int)(it % 384), chunk = (int)((it / 384) % 128), b = (int)(it / (384 * 128));
        const int c = cp * 2;
        float lb[2][2];
#pragma unroll
        for (int d = 0; d < 2; ++d)
#pragma unroll
            for (int e = 0; e < 2; ++e) { float den = 0.f, num = 0.f;
                for (int i = 0; i < 4; ++i) { const float ev = expf(P.hgrn_lb[(size_t)i * 2 * MIXW + d * MIXW + c + e]); den += ev; if (i >= 1 && i <= layer) num += ev; }
                lb[d][e] = num / den; }
        bf16_t* base = p + ((size_t)b * SEQ + chunk * 64) * 4096 + c;
        bf16_t* qf = QF + ((size_t)b * SEQ + chunk * 64) * MIXW + c;
        const float QS = 0.08838834764831845f;
        float cum0 = 0.f, cum1 = 0.f;
        for (int t = 0; t < 64; ++t) {
            const unsigned qw = *(const unsigned*)(base + (size_t)t * 4096), zw = *(const unsigned*)(base + (size_t)t * 4096 + 3 * MIXW);
            const float q0 = bflo(qw), q1 = bfhi(qw), z0 = bflo(zw), z1 = bfhi(zw);
            const float sg0 = sigmoidf_(z0), sg1 = sigmoidf_(z1);
            const float f0 = lb[0][0] + (1.f - lb[0][0]) * sg0, f1 = lb[0][1] + (1.f - lb[0][1]) * sg1;
            cum0 += __logf(f0); cum1 += __logf(f1);
            const float e0 = __expf(cum0), e1 = __expf(cum1);
            *(unsigned*)(qf + (size_t)t * MIXW) = cvt_pk_bf16(siluf_(q0) * QS * e0, siluf_(q1) * QS * e1);
            *(unsigned*)(base + (size_t)t * 4096 + 3 * MIXW) = cvt_pk_bf16((1.f - lb[0][0]) * (1.f - sg0) / e0, (1.f - lb[0][1]) * (1.f - sg1) / e1);
        }
        { float* el = elast + ((size_t)(0 * 4 + b) * 128 + chunk) * MIXW + c; el[0] = __expf(cum0); el[1] = __expf(cum1); }
        cum0 = 0.f; cum1 = 0.f;
        for (int t = 63; t >= 0; --t) {
            const unsigned qw = *(const unsigned*)(base + (size_t)t * 4096), zw = *(const unsigned*)(base + (size_t)t * 4096 + 4 * MIXW);
            const float q0 = bflo(qw), q1 = bfhi(qw), z0 = bflo(zw), z1 = bfhi(zw);
            const float sg0 = sigmoidf_(z0), sg1 = sigmoidf_(z1);
            const float f0 = lb[1][0] + (1.f - lb[1][0]) * sg0, f1 = lb[1][1] + (1.f - lb[1][1]) * sg1;
            cum0 += __logf(f0); cum1 += __logf(f1);
            const float e0 = __expf(cum0), e1 = __expf(cum1);
            *(unsigned*)(base + (size_t)t * 4096) = cvt_pk_bf16(siluf_(q0) * QS * e0, siluf_(q1) * QS * e1);
            *(unsigned*)(base + (size_t)t * 4096 + 4 * MIXW) = cvt_pk_bf16((1.f - lb[1][0]) * (1.f - sg0) / e0, (1.f - lb[1][1]) * (1.f - sg1) / e1);
        }
        { float* el = elast + ((size_t)(1 * 4 + b) * 128 + chunk) * MIXW + c; el[0] = __expf(cum0); el[1] = __expf(cum1); }
    }
}

__device__ __forceinline__ void hgrn_scan(const Params& P, LAS unsigned char* lds, const bf16_t* p, const bf16_t* QF, const float* elast, bf16_t* mix, bf16_t* OB) {
    constexpr int RP = 272, TP = 136;
    constexpr int OQ = 0, OK = 64 * RP, OKT = 2 * 64 * RP, OVT = OKT + 128 * TP, INB = OVT + 32 * TP;
    constexpr int SBB = 32 * RP, OSB = 0, INB0 = 2 * SBB;
    const int tid = otid(), lane = tid & 63, wid = tid >> 6, l15 = lane & 15, quad = lane >> 4;
    const int keg = (wid & 3) * 4 + (lane & 3), kpair = (wid >> 2) * 16 + (lane >> 2);
    const int veg = lane & 3, vpair = wid * 16 + (lane >> 2); const bool vact = wid < 2;
    const int vb = wid & 1, tb = wid >> 1;
    for (int item = blockIdx.x; item < 192; item += gridDim.x) {
        const int dir = item / 96, r = item % 96, b = r / 24, h = (r % 24) >> 2, vs = r & 3;
        const bf16_t* qsrc = dir == 0 ? QF + (size_t)b * SEQ * MIXW + h * 128 : p + (size_t)b * SEQ * 4096 + h * 128;
        const int ldqs = dir == 0 ? MIXW : 4096;
        const bf16_t* ksrc = p + (size_t)b * SEQ * 4096 + (3 + dir) * MIXW + h * 128;
        const bf16_t* vsrc = p + (size_t)b * SEQ * 4096 + MIXW + h * 128 + vs * 32;
        const float* elp = elast + (size_t)(dir * 4 + b) * 128 * MIXW + h * 128 + wid * 16 + l15;
        bf16_t* osrc = dir == 0 ? mix + (size_t)b * SEQ * D + h * 128 + vs * 32 : OB + (size_t)b * SEQ * MIXW + h * 128 + vs * 32;
        const int ldo = dir == 0 ? D : MIXW;
        u32x4 qreg[2], kreg[2], vreg[2]; float elreg = 0.f;
        auto gload = [&](int chunk) {
            const size_t t0 = (size_t)chunk * 64;
#pragma unroll
            for (int i = 0; i < 2; ++i) { const int c = tid + i * 512, ch = c & 15, row = c >> 4; qreg[i] = *(const u32x4*)(qsrc + (t0 + row) * ldqs + ch * 8); }
            kreg[0] = *(const u32x4*)(ksrc + (t0 + 2 * kpair) * 4096 + keg * 8); kreg[1] = *(const u32x4*)(ksrc + (t0 + 2 * kpair + 1) * 4096 + keg * 8);
            if (vact) { vreg[0] = *(const u32x4*)(vsrc + (t0 + 2 * vpair) * 4096 + veg * 8); vreg[1] = *(const u32x4*)(vsrc + (t0 + 2 * vpair + 1) * 4096 + veg * 8); }
            elreg = elp[(size_t)chunk * MIXW];
        };
        auto lstore = [&](int buf) {
            LAS unsigned char* bb = lds + INB0 + buf * INB;
#pragma unroll
            for (int i = 0; i < 2; ++i) { const int c = tid + i * 512, ch = c & 15, row = c >> 4; *(LAS u32x4*)(bb + OQ + row * RP + ch * 16) = qreg[i]; }
            *(LAS u32x4*)(bb + OK + (2 * kpair) * RP + keg * 16) = kreg[0]; *(LAS u32x4*)(bb + OK + (2 * kpair + 1) * RP + keg * 16) = kreg[1];
            { const unsigned a[4] = {kreg[0].x, kreg[0].y, kreg[0].z, kreg[0].w}, c2[4] = {kreg[1].x, kreg[1].y, kreg[1].z, kreg[1].w};
#pragma unroll
              for (int i = 0; i < 4; ++i) { *(LAS unsigned*)(bb + OKT + (keg * 8 + 2 * i) * TP + kpair * 4) = (a[i] & 0xffffu) | (c2[i] << 16);
                  *(LAS unsigned*)(bb + OKT + (keg * 8 + 2 * i + 1) * TP + kpair * 4) = (a[i] >> 16) | (c2[i] & 0xffff0000u); } }
            if (vact) { const unsigned a[4] = {vreg[0].x, vreg[0].y, vreg[0].z, vreg[0].w}, c2[4] = {vreg[1].x, vreg[1].y, vreg[1].z, vreg[1].w};
#pragma unroll
              for (int i = 0; i < 4; ++i) { *(LAS unsigned*)(bb + OVT + (veg * 8 + 2 * i) * TP + vpair * 4) = (a[i] & 0xffffu) | (c2[i] << 16);
                  *(LAS unsigned*)(bb + OVT + (veg * 8 + 2 * i + 1) * TP + vpair * 4) = (a[i] >> 16) | (c2[i] & 0xffff0000u); } }
        };
        for (int i = tid; i < SBB / 4; i += 512) *(LAS unsigned*)(lds + OSB + i * 4) = 0u;
        f32x4 Sacc[2] = {(f32x4){0.f, 0.f, 0.f, 0.f}, (f32x4){0.f, 0.f, 0.f, 0.f}};
        gload(dir == 0 ? 0 : 127); lstore(0); float elcur = elreg; __syncthreads();
        for (int step = 0; step < 128; ++step) {
            const int chunk = dir == 0 ? step : 127 - step;
            LAS unsigned char* bb = lds + INB0 + (step & 1) * INB; LAS unsigned char* sbc = lds + OSB + (step & 1) * SBB; LAS unsigned char* sbn = lds + OSB + ((step + 1) & 1) * SBB;
            if (step + 1 < 128) gload(dir == 0 ? step + 1 : 126 - step);
            bf16x8 Qfr[4];
#pragma unroll
            for (int ks = 0; ks < 4; ++ks) Qfr[ks] = *(const LAS bf16x8*)(bb + OQ + (tb * 16 + l15) * RP + ks * 64 + quad * 16);
            f32x4 oacc = (f32x4){0.f, 0.f, 0.f, 0.f};
#pragma unroll
#ifndef T_NOSTATE
            for (int ks = 0; ks < 4; ++ks) { const bf16x8 a = *(const LAS bf16x8*)(sbc + (vb * 16 + l15) * RP + ks * 64 + quad * 16); oacc = mfma16(a, Qfr[ks], oacc); }
#endif
            f32x4 A4[4];
#pragma unroll
            for (int sb = 0; sb < 4; ++sb) { A4[sb] = (f32x4){0.f, 0.f, 0.f, 0.f};
                const bool need = dir == 0 ? (sb <= tb) : (sb >= tb);
                if (need) {
#pragma unroll
                    for (int ks = 0; ks < 4; ++ks) { const bf16x8 a = *(const LAS bf16x8*)(bb + OK + (sb * 16 + l15) * RP + ks * 64 + quad * 16); A4[sb] = mfma16(a, Qfr[ks], A4[sb]); }
                    if (sb == tb) {
#pragma unroll
                        for (int j = 0; j < 4; ++j) { const int s = quad * 4 + j; const bool keep = dir == 0 ? (s <= l15) : (s >= l15); A4[sb][j] = keep ? A4[sb][j] : 0.f; }
                    }
                } }
#ifndef T_NOINTRA
#pragma unroll
            for (int g = 0; g < 2; ++g) { u32x4 w; w.x = cvt_pk_bf16(A4[2 * g][0], A4[2 * g][1]); w.y = cvt_pk_bf16(A4[2 * g][2], A4[2 * g][3]);
                w.z = cvt_pk_bf16(A4[2 * g + 1][0], A4[2 * g + 1][1]); w.w = cvt_pk_bf16(A4[2 * g + 1][2], A4[2 * g + 1][3]);
                const LAS unsigned char* vp = bb + OVT + (vb * 16 + l15) * TP + (32 * g + 4 * quad) * 2;
                const bf16x8 a = mk8(*(const LAS u32x2*)vp, *(const LAS u32x2*)(vp + 32));
                oacc = mfma16(a, __builtin_bit_cast(bf16x8, w), oacc); }
#endif
            { u32x2 w; w.x = cvt_pk_bf16(oacc[0], oacc[1]); w.y = cvt_pk_bf16(oacc[2], oacc[3]);
              *(u32x2*)(osrc + ((size_t)chunk * 64 + tb * 16 + l15) * ldo + vb * 16 + quad * 4) = w; }
#pragma unroll
            for (int v2 = 0; v2 < 2; ++v2) {
#pragma unroll
                for (int g = 0; g < 2; ++g) { const LAS unsigned char* vp = bb + OVT + (v2 * 16 + l15) * TP + (32 * g + 8 * quad) * 2;
                    const LAS unsigned char* kp = bb + OKT + (wid * 16 + l15) * TP + (32 * g + 8 * quad) * 2;
                    Sacc[v2] = mfma16(mk8(*(const LAS u32x2*)vp, *(const LAS u32x2*)(vp + 8)), mk8(*(const LAS u32x2*)kp, *(const LAS u32x2*)(kp + 8)), Sacc[v2]); }
                Sacc[v2] = Sacc[v2] * elcur;
#pragma unroll
                for (int j = 0; j < 4; ++j) *(LAS unsigned short*)(sbn + (v2 * 16 + quad * 4 + j) * RP + (wid * 16 + l15) * 2) = (unsigned short)(cvt_pk_bf16(Sacc[v2][j], 0.f) & 0xffffu);
            }
            if (step + 1 < 128) { lstore((step + 1) & 1); elcur = elreg; }
            __syncthreads();
        }
    }
}
__device__ __forceinline__ void hgrn_combine(const Params& P, const bf16_t* p, bf16_t* mix, const bf16_t* OB) {
    const int lane = otid() & 63, wid = otid() >> 6, grp = lane >> 4, l15 = lane & 15;
    const size_t total = (size_t)NTOK * 6 / 4;
    for (size_t it = (size_t)blockIdx.x * 8 + wid; it < total; it += (size_t)gridDim.x * 8) {
        const size_t pair = it * 4 + grp; const size_t tok = pair / 6; const int h = (int)(pair % 6); const int c = h * 128 + l15 * 8;
        float a[8], bq[8], gg[8], o[8];
        unpack8(*(const u32x4*)(mix + tok * D + c), a); unpack8(*(const u32x4*)(OB + tok * MIXW + c), bq); unpack8(*(const u32x4*)(p + tok * 4096 + 2 * MIXW + c), gg);
        float ss = 0.f;
#pragma unroll
        for (int i = 0; i < 8; ++i) { o[i] = a[i] + bq[i]; ss += o[i] * o[i]; }
        ss += __shfl_xor(ss, 1); ss += __shfl_xor(ss, 2); ss += __shfl_xor(ss, 4); ss += __shfl_xor(ss, 8);
        const float r = 1.0f / sqrtf(ss * (1.0f / 128.f) + LN_EPS);
        const f32x4 w0 = *(const f32x4*)(P.hgrn_norm + c), w1 = *(const f32x4*)(P.hgrn_norm + c + 4);
        const float wn[8] = {w0.x, w0.y, w0.z, w0.w, w1.x, w1.y, w1.z, w1.w};
#pragma unroll
        for (int i = 0; i < 8; ++i) o[i] = o[i] * r * wn[i] * siluf_(gg[i]);
        u32x4 ow; ow.x = cvt_pk_bf16(o[0], o[1]); ow.y = cvt_pk_bf16(o[2], o[3]); ow.z = cvt_pk_bf16(o[4], o[5]); ow.w = cvt_pk_bf16(o[6], o[7]);
        *(u32x4*)(mix + tok * D + c) = ow;
    }
}


__device__ __forceinline__ void gsync(cg::grid_group& grid) {
    asm volatile("s_waitcnt vmcnt(0) lgkmcnt(0)" ::: "memory");
    __syncthreads();
    if (otid() < 64) { __builtin_amdgcn_fence(__ATOMIC_RELEASE, ""); asm volatile("s_waitcnt vmcnt(0)" ::: "memory"); }
    __syncthreads();
    grid.sync();
    __builtin_amdgcn_fence(__ATOMIC_ACQUIRE, "");
    asm volatile("s_waitcnt vmcnt(0)" ::: "memory");
    __syncthreads();
}
#ifdef DBG_STOP
__device__ __forceinline__ void dbg_dump_bf16(float* out, const bf16_t* src, int ld) {
    for (size_t i = (size_t)blockIdx.x * 512 + otid(); i < (size_t)NTOK * D; i += (size_t)gridDim.x * 512) { const size_t t = i / D, c = i % D; float v = bf2f(src[t * ld + c]); out[i] = (v == v && fabsf(v) < 1e30f) ? v : 12345.f; }
}
__device__ __forceinline__ void dbg_san(float* out) {
    for (size_t i = (size_t)blockIdx.x * 512 + otid(); i < (size_t)NTOK * D; i += (size_t)gridDim.x * 512) { float v = out[i]; out[i] = (v == v && fabsf(v) < 1e30f) ? v : 12345.f; }
}
#define DBG_AT(n, code) if (DBG_STOP == (n)) { gsync(grid); code; return; }
#else
#define DBG_AT(n, code)
#endif
constexpr int NPH = 1 + 4 * 12 + 2;
__global__ void __launch_bounds__(512) mega_fwd(Params P, int lo, int hi) {
    extern __shared__ __attribute__((aligned(16))) unsigned char shm[];
    LAS unsigned char* lds = (LAS unsigned char*)shm;
    cg::grid_group grid = cg::this_grid();
    unsigned char* ws = P.ws;
    bf16_t* Wt_in = (bf16_t*)(ws + WS_WIN); bf16_t* Wt_o = (bf16_t*)(ws + WS_WO); bf16_t* Wt_up = (bf16_t*)(ws + WS_WUP); bf16_t* Wt_dn = (bf16_t*)(ws + WS_WDN);
    bf16_t* xb = (bf16_t*)(ws + WS_XB); bf16_t* pbuf = (bf16_t*)(ws + WS_BIG); bf16_t* mix = (bf16_t*)(ws + WS_BIG + BIG_MIX);
    bf16_t* gbuf = (bf16_t*)(ws + WS_BIG); bf16_t* ubuf = (bf16_t*)(ws + WS_BIG + BIG_U); bf16_t* OB = (bf16_t*)(ws + WS_OB);
    float* elast = (float*)(ws + WS_ELAST);
    int ph = 0;
#define SEG(...) { if (ph >= lo && ph < hi) { __VA_ARGS__; if (ph + 1 < hi) gsync(grid); } ++ph; }
    SEG(convert_prologue(P, lds); convert_layer(P, 0, lds))
    for (int layer = 0; layer < 4; ++layer) {
        const int kind = layer % 3; const int NIN = kind == 1 ? 4096 : 2560;
        SEG(if (layer == 0) { EpiBf16P E; E.O = (bf16_t*)(ws + WS_KVM); E.ldc = 2048; run_gemm(lds, (const bf16_t*)(ws + WS_MEMB), (const bf16_t*)(ws + WS_WKV), 1024, 2048, D, E); }
            { EpiBf16P E; E.O = pbuf; E.ldc = NIN; run_gemm(lds, xb, Wt_in, NTOK, NIN, D, E); })
        if (kind == 1) {
            SEG(hgrn_prep(P, pbuf, xb, elast, layer))
            SEG(hgrn_scan(P, lds, pbuf, xb, elast, mix, OB))
        }
        SEG(if (kind == 0) diffattn_phase(P, lds, pbuf, mix, layer);
            else if (kind == 2) shortconv_phase(pbuf, 2560, mix, P.conv_w + (size_t)(layer / 3) * 3 * MIXW);
            else hgrn_combine(P, pbuf, mix, OB);
            __syncthreads();
            memattn_phase(P, lds, pbuf, NIN, NIN - 256, mix, layer))
        SEG({ EpiResid E; E.io = P.out; E.xin = layer == 0 ? P.x : P.out; run_gemm(lds, mix, Wt_o, NTOK, D, D, E); })
        SEG(ln_phase(P.out, xb, P.ln_gain + (size_t)layer * 2 * D, P.ln_bias + (size_t)layer * 2 * D))
        for (int part = 0; part < 3; ++part) {
            const int tile0 = part * 8, ntile = part < 2 ? 8 : 6;
            SEG({ EpiBf16P E; E.O = ubuf; E.ldc = ntile * 256; run_gemm(lds, xb, Wt_up + (size_t)tile0 * 256 * D, NTOK, ntile * 256, D, E); })
            SEG(gate_phase(ubuf, ntile * 256, tile0, ntile, gbuf, P.ffn_conv + (size_t)layer * 3 * 2 * DFF))
        }
        SEG({ EpiResid E; E.io = P.out; E.xin = P.out; run_gemm(lds, gbuf, Wt_dn, NTOK, D, DFF, E); })
        SEG(ln_phase(P.out, xb, P.ln_gain + (size_t)layer * 2 * D + D, P.ln_bias + (size_t)layer * 2 * D + D);
            if (layer + 1 < 4) convert_layer(P, layer + 1, lds))
    }
#undef SEG
}


#ifdef DBG_LAST
__global__ void dbg_dump_k(Params P, int which) {
    float* out = P.out;
    for (size_t i = (size_t)blockIdx.x * blockDim.x + threadIdx.x; i < (size_t)NTOK * D; i += (size_t)gridDim.x * blockDim.x) {
        const size_t t = i / D, c = i % D; float v;
        if (which == 0) v = out[i];
        else if (which == 1) v = bf2f(((const bf16_t*)(P.ws + WS_XB))[i]);
        else if (which == 2) v = bf2f(((const bf16_t*)(P.ws + WS_BIG))[t * 2560 + c]);
        else if (which == 3) v = bf2f(((const bf16_t*)(P.ws + WS_BIG))[t * 4096 + c]);
        else if (which == 4) v = bf2f(((const bf16_t*)(P.ws + WS_BIG + BIG_MIX))[i]);
        else if (which == 5) v = bf2f(((const bf16_t*)(P.ws + WS_WIN))[t * 128 + c]);
        else if (which == 6) v = bf2f(((const bf16_t*)(P.ws + WS_BIG))[t * 4096 + 2304 + c]);
        else if (which == 12) v = bf2f(((const bf16_t*)(P.ws + WS_BIG + BIG_MIX))[t * 1024 + (c % 768)]);
        else if (which == 13) v = bf2f(((const bf16_t*)(P.ws + WS_BIG + BIG_MIX))[t * 1024 + 768 + (c % 256)]);
        else if (which == 8) v = bf2f(((const bf16_t*)(P.ws + WS_BIG))[t * 2560 + 1024 + c]);
        else if (which == 9) v = bf2f(((const bf16_t*)(P.ws + WS_BIG))[t * 2560 + 1536 + c]);
        else if (which == 10) v = bf2f(((const bf16_t*)(P.ws + WS_KVM))[(t % 1024) * 2048 + c]);
        else if (which == 11) v = bf2f(((const bf16_t*)(P.ws + WS_KVM))[(t % 1024) * 2048 + 1024 + c]);
        else v = bf2f(((const bf16_t*)(P.ws + WS_OB))[t * 768 + (c % 768)]);
        out[i] = (v == v && fabsf(v) < 1e30f) ? v : 12345.f;
    }
}
#endif
#ifndef N_LAUNCHES
#define N_LAUNCHES 1
#endif
extern "C" void kernel_launch(void* const* d_in, const int* in_sizes, int n_in, void* d_out, int out_size, void* d_ws, size_t ws_size, hipStream_t stream) {
    static int grid_blocks = 0;
    if (grid_blocks == 0) {
        int dev = 0, cus = 0, per_cu = 0;
        (void)hipGetDevice(&dev); (void)hipDeviceGetAttribute(&cus, hipDeviceAttributeMultiprocessorCount, dev);
        (void)hipFuncSetAttribute((const void*)mega_fwd, hipFuncAttributeMaxDynamicSharedMemorySize, LDS_BYTES);
        (void)hipOccupancyMaxActiveBlocksPerMultiprocessor(&per_cu, (const void*)mega_fwd, 512, LDS_BYTES);
        if (per_cu < 1) per_cu = 1;
        grid_blocks = cus * per_cu;
        if (grid_blocks > 256) grid_blocks = 256;
        if (ws_size < WS_END || n_in != 18) { fprintf(stderr, "kernel_launch: unexpected ws_size %zu or n_in %d\n", ws_size, n_in); grid_blocks = -1; }
    }
    if (grid_blocks < 0) return;
    Params P{};
    P.x = (const float*)d_in[0]; P.mem = (const float*)d_in[1]; P.rel_bias = (const float*)d_in[2]; P.attn_w_in = (const float*)d_in[3]; P.attn_lambda = (const float*)d_in[4];
    P.attn_subln = (const float*)d_in[5]; P.hgrn_w_in = (const float*)d_in[6]; P.hgrn_lb = (const float*)d_in[7]; P.hgrn_norm = (const float*)d_in[8]; P.conv_w_in = (const float*)d_in[9];
    P.conv_w = (const float*)d_in[10]; P.mem_w_kv = (const float*)d_in[11]; P.w_o = (const float*)d_in[12]; P.ln_gain = (const float*)d_in[13]; P.ln_bias = (const float*)d_in[14];
    P.ffn_w_up = (const float*)d_in[15]; P.ffn_conv = (const float*)d_in[16]; P.ffn_w_down = (const float*)d_in[17];
    P.out = (float*)d_out; P.ws = (unsigned char*)d_ws;
    if (N_LAUNCHES == 1) {
        int lo = 0, hi = NPH;
        void* args[] = {&P, &lo, &hi};
        hipError_t e = hipLaunchCooperativeKernel((const void*)mega_fwd, dim3(grid_blocks), dim3(512), args, LDS_BYTES, stream);
        if (e != hipSuccess) fprintf(stderr, "cooperative launch failed: %s (grid %d)\n", hipGetErrorString(e), grid_blocks);
    } else {
#ifdef DBG_LAST
        for (int ph = 0; ph <= DBG_LAST; ++ph) hipLaunchKernelGGL(mega_fwd, dim3(grid_blocks), dim3(512), LDS_BYTES, stream, P, ph, ph + 1);
        hipLaunchKernelGGL(dbg_dump_k, dim3(1024), dim3(256), 0, stream, P, DBG_BUF);
#else
        for (int ph = 0; ph < NPH; ++ph) hipLaunchKernelGGL(mega_fwd, dim3(grid_blocks), dim3(512), LDS_BYTES, stream, P, ph, ph + 1);
#endif
    }
}
```

```cpp
#include <hip/hip_runtime.h>
#include <hip/hip_cooperative_groups.h>
#include <cstdio>
namespace cg = cooperative_groups;

__device__ __forceinline__ int otid() { int t = threadIdx.x; asm volatile("" : "+v"(t)); return t; }
#ifndef PG8_WGM
#define PG8_WGM 8
#endif
#ifndef PG8_AUX
#define PG8_AUX 0
#endif
namespace pg8 {
#define PG8_LAS __attribute__((address_space(3)))
typedef unsigned short bf16_t;
typedef short bf16x8 __attribute__((ext_vector_type(8)));
typedef float f32x4 __attribute__((ext_vector_type(4)));
typedef unsigned u32x4 __attribute__((ext_vector_type(4)));
constexpr int BM = 256, BK = 64, HALF = 128, HTB = HALF * BK * 2  , STAGE_BYTES = 8 * HTB, NXCD = 8, WGM = PG8_WGM;

__host__ __device__ __forceinline__ int lds_byte(int r, int c) { const int st = (r >> 4) * 2 + (c >> 5), rr = r & 15, cc = c & 31, ob = rr * 64 + cc * 2; return st * 1024 + (ob ^ (((ob >> 9) & 1) << 5)); }
__host__ __device__ __forceinline__ void stage_rc(int b, int& R, int& C) { const int st = b / 1024, sb = b % 1024, swz = sb ^ (((sb >> 9) & 1) << 5); R = (st >> 1) * 16 + swz / 64; C = (st & 1) * 32 + (swz % 64) / 2; }
__host__ __device__ __forceinline__ int perm32(int rho) { const int n = rho >> 4, i = rho & 15; return 8 * (i >> 2) + 4 * n + (i & 3); }
struct Unit { int pm, pn; };
struct Gemm { const bf16_t* A; const bf16_t* Bt; int M, N, K; };
struct StaticOrder {
    int nM, nN, nwg, G, c;
    __host__ __device__ void init(int M, int N, int G_, int c_) { nM = M / BM; nN = N / BM; nwg = nM * nN; G = G_; c = c_; }
    __host__ __device__ bool next(int i, Unit& u) const {
        const long L = (long)i * G + c; if (L >= nwg) return false;
        int wgid = (int)L; { const int q = nwg / NXCD, r = nwg % NXCD, xcd = wgid % NXCD, off = wgid / NXCD; wgid = (xcd < r ? xcd * (q + 1) : r * (q + 1) + (xcd - r) * q) + off; }
        const int nig = WGM * nN, gid = wgid / nig, fm = gid * WGM, gsz = (nM - fm) < WGM ? (nM - fm) : WGM;
        u.pm = fm + ((wgid % nig) % gsz); u.pn = (wgid % nig) / gsz; return true;
    }
    __device__ __forceinline__ void a_ready(const Unit&) const {}
    __device__ __forceinline__ void done(const Unit&) const {}
};
typedef __bf16 pg8_bf2 __attribute__((ext_vector_type(2)));
typedef float pg8_f2 __attribute__((ext_vector_type(2)));
__device__ __forceinline__ unsigned cvt_pk_bf16(float lo, float hi) { pg8_f2 v; v.x = lo; v.y = hi; return __builtin_bit_cast(unsigned, __builtin_convertvector(v, pg8_bf2)); }
template <class Epi, class Sched, bool STAMP = false>
__device__ __forceinline__ void gemm_phase(PG8_LAS unsigned char* lds, const Gemm g, const Sched& S, const Epi& E, unsigned long long* stamps) {
    const int tid = otid(), wid = __builtin_amdgcn_readfirstlane(tid >> 6), lane = tid & 63, wr = wid >> 2, wc = wid & 3, fr = lane & 15, fq = lane >> 4;
    const int K = g.K, nt = K / BK;
    int ts_lo = 0, ts_hi = 0, nts = 0; const unsigned long long rt_entry = STAMP ? (unsigned long long)wall_clock64() : 0ull;
#define PG8_STAMP() do { if (STAMP && wid == 0 && nts < 64) { const unsigned long long _c = (unsigned long long)clock64(); \
        ts_lo = (lane == nts) ? (int)(unsigned)_c : ts_lo; ts_hi = (lane == nts) ? (int)(unsigned)(_c >> 32) : ts_hi; ++nts; } } while (0)
    PG8_STAMP();
    unsigned voffA[2], voffB[2];
#pragma unroll
    for (int i = 0; i < 2; ++i) { int R, C; stage_rc(tid * 16 + i * 8192, R, C); const int Rb = Epi::PERM ? ((R & ~31) + perm32(R & 31)) : R;
        voffA[i] = (unsigned)(R * K + C) * 2u; voffB[i] = (unsigned)(Rb * K + C) * 2u; }
    const size_t kstep = (size_t)(BK * 2);
    const size_t hstep = (size_t)HALF * K * 2;
    const size_t tstep = 2 * hstep;
    const unsigned ldsw = (unsigned)wid * 1024u;
    const int aoff = lds_byte(wr * 64 + fr, fq * 8), boff = lds_byte(wc * 32 + fr, fq * 8);
#define PG8_SA(b, h) (((b) * 2 + (h)) * HTB)
#define PG8_SB(b, h) ((4 + (b) * 2 + (h)) * HTB)
#define PG8_STAGE(bufoff, gbase, voff) do { _Pragma("unroll") for (int _i = 0; _i < 2; ++_i) \
        __builtin_amdgcn_global_load_lds((const unsigned*)((const char*)(gbase) + (voff)[_i]), (PG8_LAS unsigned*)(lds + (bufoff) + ldsw + _i * 8192), 16, 0, PG8_AUX); } while (0)
#define PG8_LDA(dst, b, h) do { _Pragma("unroll") for (int m = 0; m < 4; ++m) _Pragma("unroll") for (int k = 0; k < 2; ++k) dst[m][k] = *(const PG8_LAS bf16x8*)(lds + PG8_SA(b, h) + aoff + m * 2048 + k * 1024); } while (0)
#define PG8_LDB(dst, b, h) do { _Pragma("unroll") for (int n = 0; n < 2; ++n) _Pragma("unroll") for (int k = 0; k < 2; ++k) dst[n][k] = *(const PG8_LAS bf16x8*)(lds + PG8_SB(b, h) + boff + n * 2048 + k * 1024); } while (0)
#define PG8_MMA(ai, bj, At, Bt) do { __builtin_amdgcn_s_setprio(1); _Pragma("unroll") for (int m = 0; m < 4; ++m) _Pragma("unroll") for (int n = 0; n < 2; ++n) _Pragma("unroll") for (int k = 0; k < 2; ++k) \
        acc[ai][bj][m][n] = __builtin_amdgcn_mfma_f32_16x16x32_bf16(Bt[n][k], At[m][k], acc[ai][bj][m][n], 0, 0, 0); __builtin_amdgcn_s_setprio(0); } while (0)
#define PG8_WAIT_V(n) asm volatile("s_waitcnt vmcnt(" #n ")" ::: "memory")
#define PG8_WAIT_L(n) asm volatile("s_waitcnt lgkmcnt(" #n ")" ::: "memory")
#define PG8_BAR __builtin_amdgcn_s_barrier()
#define PG8_SCHED __builtin_amdgcn_sched_barrier(0)
    Unit cur, nxt; int ui = 0;
    if (!S.next(0, cur)) return;
    f32x4 acc[2][2][4][2];
#pragma unroll
    for (int a = 0; a < 2; ++a)
#pragma unroll
        for (int b = 0; b < 2; ++b)
#pragma unroll
            for (int m = 0; m < 4; ++m)
#pragma unroll
                for (int n = 0; n < 2; ++n) acc[a][b][m][n] = (f32x4){0.f, 0.f, 0.f, 0.f};
    bf16x8 At[4][2], B0[2][2], B1[2][2];
    const char* cA = (const char*)g.A + (size_t)cur.pm * tstep; const char* cB = (const char*)g.Bt + (size_t)cur.pn * tstep;
    S.a_ready(cur);
    PG8_STAGE(PG8_SB(0, 0), cB, voffB); PG8_STAGE(PG8_SA(0, 0), cA, voffA); PG8_STAGE(PG8_SB(0, 1), cB + hstep, voffB); PG8_STAGE(PG8_SA(0, 1), cA + hstep, voffA);
    if (wr == 1) PG8_BAR;
    PG8_WAIT_V(4); PG8_BAR;
    PG8_STAGE(PG8_SB(1, 0), cB + kstep, voffB); PG8_STAGE(PG8_SA(1, 0), cA + kstep, voffA); PG8_STAGE(PG8_SB(1, 1), cB + hstep + kstep, voffB);
    PG8_WAIT_V(6); PG8_BAR;
    PG8_STAMP();
    for (;;) {
        const bool has_next = S.next(ui + 1, nxt);
        const char* nA = has_next ? (const char*)g.A + (size_t)nxt.pm * tstep : cA; const char* nB = has_next ? (const char*)g.Bt + (size_t)nxt.pn * tstep : cB;
        for (int t = 0; t < nt; t += 2) {
            const bool last = (t == nt - 2);
            const char* a1 = cA + (size_t)(t + 1) * kstep;
            const char* a2 = last ? nA : cA + (size_t)(t + 2) * kstep; const char* b2 = last ? nB : cB + (size_t)(t + 2) * kstep;
            const char* a3 = a2 + kstep; const char* b3 = b2 + kstep;
            if (last && has_next) S.a_ready(nxt);
            PG8_LDB(B0, 0, 0); PG8_SCHED; PG8_LDA(At, 0, 0); PG8_STAGE(PG8_SA(1, 1), a1 + hstep, voffA);
            PG8_WAIT_L(8); PG8_BAR; PG8_WAIT_L(0); PG8_MMA(0, 0, At, B0); PG8_BAR; PG8_SCHED;
            PG8_LDB(B1, 0, 1); PG8_STAGE(PG8_SB(0, 0), b2, voffB);
            PG8_BAR; PG8_WAIT_L(0); PG8_MMA(0, 1, At, B1); PG8_BAR;
            PG8_LDA(At, 0, 1); PG8_STAGE(PG8_SA(0, 0), a2, voffA);
            PG8_BAR; PG8_WAIT_L(0); PG8_MMA(1, 0, At, B0); PG8_BAR; PG8_SCHED;
            PG8_STAGE(PG8_SB(0, 1), b2 + hstep, voffB);
            PG8_WAIT_V(6); PG8_BAR; PG8_MMA(1, 1, At, B1); PG8_BAR;
            PG8_LDB(B0, 1, 0); PG8_SCHED; PG8_LDA(At, 1, 0); PG8_STAGE(PG8_SA(0, 1), a2 + hstep, voffA);
            PG8_WAIT_L(8); PG8_BAR; PG8_WAIT_L(0); PG8_MMA(0, 0, At, B0); PG8_BAR; PG8_SCHED;
            PG8_LDB(B1, 1, 1); PG8_STAGE(PG8_SB(1, 0), b3, voffB);
            PG8_BAR; PG8_WAIT_L(0); PG8_MMA(0, 1, At, B1); PG8_BAR;
            PG8_LDA(At, 1, 1); PG8_STAGE(PG8_SA(1, 0), a3, voffA);
            PG8_BAR; PG8_WAIT_L(0); PG8_MMA(1, 0, At, B0); PG8_BAR; PG8_SCHED;
            PG8_STAGE(PG8_SB(1, 1), b3 + hstep, voffB);
            PG8_WAIT_V(6); PG8_BAR; PG8_MMA(1, 1, At, B1); PG8_BAR;
        }
        PG8_STAMP();
        if constexpr (!Epi::AFTER_DRAIN) { E(acc, cur, wr, wc, fr, fq); S.done(cur); }
        PG8_STAMP();
        if (!has_next) break;
#pragma unroll
        for (int a = 0; a < 2; ++a)
#pragma unroll
            for (int b = 0; b < 2; ++b)
#pragma unroll
                for (int m = 0; m < 4; ++m)
#pragma unroll
                    for (int n = 0; n < 2; ++n) acc[a][b][m][n] = (f32x4){0.f, 0.f, 0.f, 0.f};
        cur = nxt; cA = nA; cB = nB; ++ui;
    }
    PG8_WAIT_V(0);
    if (wr == 0) PG8_BAR;
    PG8_BAR;
    if constexpr (Epi::AFTER_DRAIN) { E.fused(acc, cur, wr, wc, fr, fq, lds, wid, lane); S.done(cur); }
    PG8_STAMP();
    if (STAMP && wid == 0) { stamps[lane] = lane < nts ? (((unsigned long long)(unsigned)ts_hi << 32) | (unsigned)ts_lo) : 0ull;
        if (lane == 62) stamps[62] = rt_entry; if (lane == 63) stamps[63] = (unsigned long long)wall_clock64(); }
#undef PG8_STAMP
#undef PG8_SA
#undef PG8_SB
#undef PG8_STAGE
#undef PG8_LDA
#undef PG8_LDB
#undef PG8_MMA
#undef PG8_WAIT_V
#undef PG8_WAIT_L
#undef PG8_BAR
#undef PG8_SCHED
}
}

using pg8::bf16_t; using pg8::bf16x8; using pg8::f32x4; using pg8::u32x4; using pg8::cvt_pk_bf16;
#define LAS PG8_LAS
typedef unsigned u32x2 __attribute__((ext_vector_type(2)));

constexpr int D = 1024, NTOK = 32768, SEQ = 8192, MIXW = 768, DFF = 2816;
constexpr float ALPHA = 1.6817928305074290f, LN_EPS = 1e-5f, LOG2E = 1.4426950408889634f;
constexpr size_t MiB = 1048576;
constexpr size_t WS_WIN = 0, WS_WO = 8 * MiB, WS_WUP = 10 * MiB, WS_WDN = 21 * MiB, WS_WKV = 27 * MiB, WS_MEMB = 31 * MiB, WS_KVM = 33 * MiB,
                 WS_ELAST = 37 * MiB, WS_XB = 40 * MiB, WS_BIG = 104 * MiB, WS_OB = 424 * MiB, WS_LNST = 472 * MiB, WS_END = 473 * MiB;
constexpr size_t BIG_MIX = 256 * MiB, BIG_U = 176 * MiB;
constexpr int LDS_BYTES = 4 * (64 * 272 + 128 * 144) + 2048;

struct Params {
    const float *x, *mem, *rel_bias, *attn_w_in, *attn_lambda, *attn_subln, *hgrn_w_in, *hgrn_lb, *hgrn_norm, *conv_w_in, *conv_w, *mem_w_kv, *w_o,
                *ln_gain, *ln_bias, *ffn_w_up, *ffn_conv, *ffn_w_down;
    float* out; unsigned char* ws;
};

__device__ __forceinline__ float bf2f(unsigned short h) { return __uint_as_float(((unsigned)h) << 16); }
__device__ __forceinline__ float bflo(unsigned w) { return __uint_as_float(w << 16); }
__device__ __forceinline__ float bfhi(unsigned w) { return __uint_as_float(w & 0xffff0000u); }
__device__ __forceinline__ float fast_exp2(float x) { return __builtin_amdgcn_exp2f(x); }
__device__ __forceinline__ float sigmoidf_(float x) { return 1.0f / (1.0f + __expf(-x)); }
__device__ __forceinline__ float siluf_(float x) { return x / (1.0f + __expf(-x)); }
__device__ __forceinline__ float fast_sigmoid(float x) { return __builtin_amdgcn_rcpf(1.0f + __builtin_amdgcn_exp2f(-1.4426950408889634f * x)); }
__device__ __forceinline__ float fast_silu(float x) { return x * fast_sigmoid(x); }

__device__ __forceinline__ void cvt_tile(const float* src, int ldsrc, int k0, int c0, bf16_t* dst, int lddst, int r0, float scale, LAS float* scr) {
    const int tid = otid();
    { const int n = tid & 63, kk = tid >> 6;
#pragma unroll
      for (int i = 0; i < 8; ++i) scr[(kk + 8 * i) * 65 + n] = src[(size_t)(k0 + kk + 8 * i) * ldsrc + c0 + n] * scale; }
    __syncthreads();
    { const int kp = tid & 31, nn = tid >> 5;
#pragma unroll
      for (int i = 0; i < 4; ++i) { const int n = nn + 16 * i;
          *(unsigned*)(dst + (size_t)(r0 + n) * lddst + k0 + 2 * kp) = cvt_pk_bf16(scr[(2 * kp) * 65 + n], scr[(2 * kp + 1) * 65 + n]); } }
    __syncthreads();
}
__device__ __forceinline__ void convert_layer(const Params& P, int layer, LAS unsigned char* lds) {
    LAS float* scr = (LAS float*)lds;
#ifdef DBG_KIND1
    const int kind = 1, jj = 0;
#else
    const int kind = layer % 3, jj = layer / 3;
#endif
    const int NIN = kind == 1 ? 4096 : 2560;
    const float* win = kind == 0 ? P.attn_w_in + (size_t)jj * D * 2560 : (kind == 1 ? P.hgrn_w_in + (size_t)jj * D * 4096 : P.conv_w_in + (size_t)jj * D * 2560);
#ifdef DBG_WALT
    bf16_t* Wt_in = (bf16_t*)(P.ws + (layer == 1 ? WS_OB : WS_WIN));
#else
    bf16_t* Wt_in = (bf16_t*)(P.ws + WS_WIN);
#endif
    bf16_t* Wt_o = (bf16_t*)(P.ws + WS_WO); bf16_t* Wt_up = (bf16_t*)(P.ws + WS_WUP); bf16_t* Wt_dn = (bf16_t*)(P.ws + WS_WDN);
    const int T_IN = (NIN / 64) * 16, T_O = 256, T_UP = 88 * 16, T_DN = 16 * 44, T_ALL = T_IN + T_O + T_UP + T_DN;
    for (int it = blockIdx.x; it < T_ALL; it += gridDim.x) {
        int r = it;
        if (r < T_IN) { const int nt = r >> 4, kt = r & 15; const int c0 = nt * 64;
            const bool qcol = (kind == 0 && c0 < MIXW) || (c0 >= NIN - 256);
            cvt_tile(win, NIN, kt * 64, c0, Wt_in, D, c0, qcol ? 0.125f * LOG2E : 1.0f, scr); continue; }
        r -= T_IN;
        if (r < T_O) { const int nt = r >> 4, kt = r & 15; cvt_tile(P.w_o + (size_t)layer * D * D, D, kt * 64, nt * 64, Wt_o, D, nt * 64, 1.0f, scr); continue; }
        r -= T_O;
        if (r < T_UP) { const int nt = r >> 4, kt = r & 15; const int j = nt >> 2, q = nt & 3; const int c0 = q < 2 ? j * 128 + q * 64 : DFF + j * 128 + (q - 2) * 64;
            cvt_tile(P.ffn_w_up + (size_t)layer * D * 2 * DFF, 2 * DFF, kt * 64, c0, Wt_up, D, nt * 64, 1.0f, scr); continue; }
        r -= T_UP;
        { const int nt = r / 44, kt = r % 44; cvt_tile(P.ffn_w_down + (size_t)layer * DFF * D, D, kt * 64, nt * 64, Wt_dn, DFF, nt * 64, 1.0f, scr); }
    }
}
__device__ __forceinline__ void convert_prologue(const Params& P, LAS unsigned char* lds) {
    LAS float* scr = (LAS float*)lds;
    bf16_t* Wt_kv = (bf16_t*)(P.ws + WS_WKV);
    for (int it = blockIdx.x; it < 512; it += gridDim.x) { const int l = it >> 7, r = it & 127, nt = r >> 4, kt = r & 15;
        cvt_tile(P.mem_w_kv + (size_t)l * D * 512, 512, kt * 64, nt * 64, Wt_kv, D, l * 512 + nt * 64, 1.0f, scr); }
    const size_t gt = (size_t)blockIdx.x * 512 + otid(), gs = (size_t)gridDim.x * 512;
    { const f32x4* s = (const f32x4*)P.x; u32x2* d = (u32x2*)(P.ws + WS_XB);
      for (size_t i = gt; i < (size_t)NTOK * D / 4; i += gs) { const f32x4 v = s[i]; u32x2 o; o.x = cvt_pk_bf16(v.x, v.y); o.y = cvt_pk_bf16(v.z, v.w); d[i] = o; } }
    { const f32x4* s = (const f32x4*)P.mem; u32x2* d = (u32x2*)(P.ws + WS_MEMB);
      for (size_t i = gt; i < (size_t)1024 * D / 4; i += gs) { const f32x4 v = s[i]; u32x2 o; o.x = cvt_pk_bf16(v.x, v.y); o.y = cvt_pk_bf16(v.z, v.w); d[i] = o; } }
}

struct EpiBf16P {
    static constexpr bool PERM = true, AFTER_DRAIN = false;
    bf16_t* O; int ldc;
    __device__ __forceinline__ void operator()(const f32x4 (&acc)[2][2][4][2], const pg8::Unit& u, int wr, int wc, int fr, int fq) const {
        const int row0 = u.pm * 256 + wr * 64 + fr, col0 = u.pn * 256 + wc * 32 + 8 * fq;
#pragma unroll
        for (int ai = 0; ai < 2; ++ai)
#pragma unroll
            for (int m = 0; m < 4; ++m) { bf16_t* rowp = O + (size_t)(row0 + ai * 128 + m * 16) * ldc + col0;
#pragma unroll
                for (int bj = 0; bj < 2; ++bj) { const f32x4 v0 = acc[ai][bj][m][0], v1 = acc[ai][bj][m][1];
                    u32x4 w; w.x = cvt_pk_bf16(v0[0], v0[1]); w.y = cvt_pk_bf16(v0[2], v0[3]); w.z = cvt_pk_bf16(v1[0], v1[1]); w.w = cvt_pk_bf16(v1[2], v1[3]);
                    *(u32x4*)(rowp + bj * 128) = w; } }
    }
};
struct EpiResid {
    static constexpr bool PERM = false, AFTER_DRAIN = false;
    float* io; const float* xin; const float* stats; const float* lg; const float* lb;
    __device__ __forceinline__ void operator()(const f32x4 (&acc)[2][2][4][2], const pg8::Unit& u, int wr, int wc, int fr, int fq) const {
        const int row0 = u.pm * 256 + wr * 64 + fr, col0 = u.pn * 256 + wc * 32 + 4 * fq;
#pragma unroll
        for (int bj = 0; bj < 2; ++bj)
#pragma unroll
            for (int n = 0; n < 2; ++n) {
                const int cc = col0 + bj * 128 + n * 16;
                f32x4 gv = (f32x4){1.f, 1.f, 1.f, 1.f}, bv = (f32x4){0.f, 0.f, 0.f, 0.f};
                if (stats) { gv = *(const f32x4*)(lg + cc); bv = *(const f32x4*)(lb + cc); }
#pragma unroll
                for (int ai = 0; ai < 2; ++ai)
#pragma unroll
                    for (int m = 0; m < 4; ++m) { const int row = row0 + ai * 128 + m * 16; const size_t ro = (size_t)row * D + cc;
                        f32x4 xv = *(const f32x4*)(xin + ro);
                        if (stats) { const float mean = stats[2 * row], rstd = stats[2 * row + 1]; xv = (xv - mean) * rstd * gv + bv; }
                        *(f32x4*)(io + ro) = xv * ALPHA + acc[ai][bj][m][n]; }
            }
    }
};

__device__ __forceinline__ float dpp_ror1(float x) { return __builtin_bit_cast(float, __builtin_amdgcn_update_dpp(0, __builtin_bit_cast(int, x), 0x121, 0xf, 0xf, false)); }
__device__ __forceinline__ float dpp_ror15(float x) { return __builtin_bit_cast(float, __builtin_amdgcn_update_dpp(0, __builtin_bit_cast(int, x), 0x12f, 0xf, 0xf, false)); }
struct EpiGate {
    static constexpr bool PERM = false, AFTER_DRAIN = false;
    bf16_t* g; float* edge; const float* cw; LAS unsigned char* xl;
    __device__ __forceinline__ void operator()(const f32x4 (&acc)[2][2][4][2], const pg8::Unit& u, int wr, int wc, int fr, int fq) const {
        LAS f32x4* X = (LAS f32x4*)xl;
        const int cq = wc * 8 + fq;
        if (fr == 0) {
#pragma unroll
            for (int ai = 0; ai < 2; ++ai)
#pragma unroll
                for (int bj = 0; bj < 2; ++bj)
#pragma unroll
                    for (int n = 0; n < 2; ++n) X[(((ai * 2 + wr) * 2 + 0) * 2 + bj) * 32 + cq + 4 * n] = acc[ai][bj][0][n];
        }
        if (fr == 15) {
#pragma unroll
            for (int ai = 0; ai < 2; ++ai)
#pragma unroll
                for (int bj = 0; bj < 2; ++bj)
#pragma unroll
                    for (int n = 0; n < 2; ++n) X[(((ai * 2 + wr) * 2 + 1) * 2 + bj) * 32 + cq + 4 * n] = acc[ai][bj][3][n];
        }
        asm volatile("s_waitcnt lgkmcnt(0)" ::: "memory");
        __builtin_amdgcn_s_barrier(); __builtin_amdgcn_s_barrier();
        asm volatile("" ::: "memory");
        const int colbase = u.pn * 128 + wc * 32 + 4 * fq;
        const size_t row0 = (size_t)u.pm * 256 + wr * 64 + fr;
#pragma unroll
        for (int ai = 0; ai < 2; ++ai) {
            const int seg = ai * 2 + wr;
#pragma unroll
            for (int n = 0; n < 2; ++n) {
                f32x4 h[2][4];
#pragma unroll
                for (int bj = 0; bj < 2; ++bj) {
                    f32x4 wgt[3];
#pragma unroll
                    for (int t = 0; t < 3; ++t) wgt[t] = *(const f32x4*)(cw + (size_t)t * 2 * DFF + bj * DFF + colbase + 16 * n);
                    const f32x4 hp = seg > 0 ? X[(((seg - 1) * 2 + 1) * 2 + bj) * 32 + cq + 4 * n] : (f32x4){0.f, 0.f, 0.f, 0.f};
                    const f32x4 hn = seg < 3 ? X[(((seg + 1) * 2 + 0) * 2 + bj) * 32 + cq + 4 * n] : (f32x4){0.f, 0.f, 0.f, 0.f};
#pragma unroll
                    for (int i = 0; i < 4; ++i) {
                        float R[4], L[4];
#pragma unroll
                        for (int m = 0; m < 4; ++m) { R[m] = dpp_ror1(acc[ai][bj][m][n][i]); L[m] = dpp_ror15(acc[ai][bj][m][n][i]); }
#pragma unroll
                        for (int m = 0; m < 4; ++m) {
                            const float pv_ = fr == 0 ? (m == 0 ? hp[i] : R[m == 0 ? 0 : m - 1]) : R[m];
                            const float nx_ = fr == 15 ? (m == 3 ? hn[i] : L[m == 3 ? 3 : m + 1]) : L[m];
                            h[bj][m][i] = wgt[0][i] * pv_ + wgt[1][i] * acc[ai][bj][m][n][i] + wgt[2][i] * nx_;
                        }
                    }
                    __builtin_amdgcn_sched_barrier(0);
                }
#pragma unroll
                for (int m = 0; m < 4; ++m) {
                    const f32x4 a = h[0][m], v = h[1][m];
                    u32x2 w; w.x = cvt_pk_bf16(fast_silu(a[0]) * v[0], fast_silu(a[1]) * v[1]); w.y = cvt_pk_bf16(fast_silu(a[2]) * v[2], fast_silu(a[3]) * v[3]);
                    *(u32x2*)(g + (row0 + ai * 128 + m * 16) * DFF + colbase + 16 * n) = w;
                }
                __builtin_amdgcn_sched_barrier(0);
            }
        }
        const int ecol = u.pn * 256 + wc * 32 + 4 * fq;
        if (wr == 0 && fr < 2) {
#pragma unroll
            for (int bj = 0; bj < 2; ++bj)
#pragma unroll
                for (int n = 0; n < 2; ++n) *(f32x4*)(edge + ((size_t)u.pm * 4 + fr) * (2 * DFF) + ecol + bj * 128 + 16 * n) = acc[0][bj][0][n];
        }
        if (wr == 1 && fr >= 14) {
#pragma unroll
            for (int bj = 0; bj < 2; ++bj)
#pragma unroll
                for (int n = 0; n < 2; ++n) *(f32x4*)(edge + ((size_t)u.pm * 4 + (fr - 12)) * (2 * DFF) + ecol + bj * 128 + 16 * n) = acc[1][bj][3][n];
        }
    }
};
__device__ __forceinline__ void gate_fixup(const float* edge, bf16_t* g, const float* cw) {
    const int total = 128 * 2 * DFF;
    for (int it = blockIdx.x * 512 + otid(); it < total; it += gridDim.x * 512) {
        const int c = it % DFF, rr = (it / DFF) & 1, pm = it / (2 * DFF);
        const int pn = c >> 7, cc = c & 127, ea = pn * 256 + cc, ev = ea + 128;
        const float* E = edge + (size_t)pm * 4 * (2 * DFF);
        float pa, pv_, ca, cv, na, nv;
        if (rr == 0) {
            ca = E[0 * 2 * DFF + ea]; cv = E[0 * 2 * DFF + ev]; na = E[1 * 2 * DFF + ea]; nv = E[1 * 2 * DFF + ev];
            if ((pm & 31) == 0) { pa = 0.f; pv_ = 0.f; } else { pa = (E - 4 * (2 * DFF))[3 * 2 * DFF + ea]; pv_ = (E - 4 * (2 * DFF))[3 * 2 * DFF + ev]; }
        } else {
            pa = E[2 * 2 * DFF + ea]; pv_ = E[2 * 2 * DFF + ev]; ca = E[3 * 2 * DFF + ea]; cv = E[3 * 2 * DFF + ev];
            if ((pm & 31) == 31) { na = 0.f; nv = 0.f; } else { na = (E + 4 * (2 * DFF))[0 * 2 * DFF + ea]; nv = (E + 4 * (2 * DFF))[0 * 2 * DFF + ev]; }
        }
        const float ha = cw[c] * pa + cw[2 * DFF + c] * ca + cw[4 * DFF + c] * na;
        const float hv = cw[DFF + c] * pv_ + cw[3 * DFF + c] * cv + cw[5 * DFF + c] * nv;
        const float o = fast_silu(ha) * hv;
        g[((size_t)pm * 256 + rr * 255) * DFF + c] = (bf16_t)(cvt_pk_bf16(o, 0.f) & 0xffffu);
    }
}
template <class Epi>
__device__ __forceinline__ void run_gemm(LAS unsigned char* lds, const bf16_t* A, const bf16_t* Bt, int M, int N, int K, const Epi& E) {
    pg8::StaticOrder S; S.init(M, N, (int)gridDim.x, (int)blockIdx.x);
    pg8::Gemm g; g.A = A; g.Bt = Bt; g.M = M; g.N = N; g.K = K;
    pg8::gemm_phase<Epi, pg8::StaticOrder, false>(lds, g, S, E, nullptr);
    __syncthreads();
}

__device__ __forceinline__ float wave_sum(float v) {
#pragma unroll
    for (int o = 32; o >= 1; o >>= 1) v += __shfl_xor(v, o);
    return v;
}
__device__ __forceinline__ void ln_phase(float* io, bf16_t* xb, const float* gain, const float* bias, float* stats, bool wf32) {
    const int lane = otid() & 63, wid = otid() >> 6;
    f32x4 gv[4], bv[4];
#pragma unroll
    for (int j = 0; j < 4; ++j) { gv[j] = ((const f32x4*)gain)[lane + 64 * j]; bv[j] = ((const f32x4*)bias)[lane + 64 * j]; }
    for (int rg = (blockIdx.x * 8 + wid) * 4; rg < NTOK / 4; rg += gridDim.x * 8 * 4)
    for (int r0 = 0; r0 < 16; r0 += 4) {
        f32x4 v[4][4];
#pragma unroll
        for (int r = 0; r < 4; ++r) { const int row = rg * 4 + r0 + r; const f32x4* xr = (const f32x4*)(io + (size_t)row * D) + lane;
#pragma unroll
            for (int j = 0; j < 4; ++j) v[r][j] = xr[64 * j]; }
#pragma unroll
        for (int r = 0; r < 4; ++r) {
            const int row = rg * 4 + r0 + r;
            float s = 0.f;
#pragma unroll
            for (int j = 0; j < 4; ++j) s += (v[r][j].x + v[r][j].y) + (v[r][j].z + v[r][j].w);
            const float mean = wave_sum(s) * (1.f / D); float s2 = 0.f;
#pragma unroll
            for (int j = 0; j < 4; ++j) { v[r][j] = v[r][j] - mean; s2 += (v[r][j].x * v[r][j].x + v[r][j].y * v[r][j].y) + (v[r][j].z * v[r][j].z + v[r][j].w * v[r][j].w); }
            const float rstd = 1.0f / sqrtf(wave_sum(s2) * (1.f / D) + LN_EPS);
            f32x4* xr = (f32x4*)(io + (size_t)row * D) + lane; u32x2* o8 = (u32x2*)(xb + (size_t)row * D) + lane;
            if (lane == 0) { stats[2 * row] = mean; stats[2 * row + 1] = rstd; }
#pragma unroll
            for (int j = 0; j < 4; ++j) { const f32x4 y = v[r][j] * rstd * gv[j] + bv[j]; if (wf32) xr[64 * j] = y;
                u32x2 o; o.x = cvt_pk_bf16(y.x, y.y); o.y = cvt_pk_bf16(y.z, y.w); o8[64 * j] = o; }
        }
    }
}

__device__ __forceinline__ void unpack8(const u32x4 w, float (&f)[8]) {
    f[0] = bflo(w.x); f[1] = bfhi(w.x); f[2] = bflo(w.y); f[3] = bfhi(w.y); f[4] = bflo(w.z); f[5] = bfhi(w.z); f[6] = bflo(w.w); f[7] = bfhi(w.w);
}
__device__ __forceinline__ void gate_phase(const bf16_t* u, int ldu, int tile0, int ntile, bf16_t* g, const float* cw  ) {
    const int tid = otid();
    const int combo = tid & 127, sub = tid >> 7;
    const int jj = combo >> 4, cg = combo & 15;
    if (jj >= ntile) return;
    const int ca = (tile0 + jj) * 128 + cg * 8, cv = DFF + ca;
    float wa[3][8], wv[3][8];
#pragma unroll
    for (int t = 0; t < 3; ++t)
#pragma unroll
        for (int i = 0; i < 8; ++i) { wa[t][i] = cw[(size_t)t * 2 * DFF + ca + i]; wv[t][i] = cw[(size_t)t * 2 * DFF + cv + i]; }
    const u32x4 zero4 = (u32x4){0u, 0u, 0u, 0u};
    for (int strip = blockIdx.x; strip < NTOK / 32; strip += gridDim.x) {
        const int t0 = strip * 32 + sub * 8;
        const bf16_t* ua = u + (size_t)t0 * ldu + jj * 256 + cg * 8;
        u32x4 ra[10], rv[10];
#pragma unroll
        for (int r = 0; r < 10; ++r) {
            const int tt = t0 - 1 + r;
            const bool valid = !((r == 0 && (t0 & (SEQ - 1)) == 0) || (r == 9 && ((t0 + 8) & (SEQ - 1)) == 0));
            if (valid) { ra[r] = *(const u32x4*)(ua + (ptrdiff_t)(r - 1) * ldu); rv[r] = *(const u32x4*)(ua + (ptrdiff_t)(r - 1) * ldu + 128); }
            else { ra[r] = zero4; rv[r] = zero4; }
            (void)tt;
        }
#pragma unroll
        for (int t = 0; t < 8; ++t) {
            float fpa[8], fca[8], fna[8], fpv[8], fcv[8], fnv[8], o[8];
            unpack8(ra[t], fpa); unpack8(ra[t + 1], fca); unpack8(ra[t + 2], fna); unpack8(rv[t], fpv); unpack8(rv[t + 1], fcv); unpack8(rv[t + 2], fnv);
#pragma unroll
            for (int i = 0; i < 8; ++i) { const float ha = wa[0][i] * fpa[i] + wa[1][i] * fca[i] + wa[2][i] * fna[i];
                const float hv = wv[0][i] * fpv[i] + wv[1][i] * fcv[i] + wv[2][i] * fnv[i]; o[i] = siluf_(ha) * hv; }
            u32x4 w; w.x = cvt_pk_bf16(o[0], o[1]); w.y = cvt_pk_bf16(o[2], o[3]); w.z = cvt_pk_bf16(o[4], o[5]); w.w = cvt_pk_bf16(o[6], o[7]);
            *(u32x4*)(g + (size_t)(t0 + t) * DFF + ca) = w;
        }
    }
}

__device__ __forceinline__ void shortconv_phase(const bf16_t* p, int ldp, bf16_t* mix, const float* cw  ) {
    const int tid = otid();
    if (tid >= 384) return;
    const int cg = tid % 96, sub = tid / 96, c = cg * 8;
    float w[3][8];
#pragma unroll
    for (int t = 0; t < 3; ++t)
#pragma unroll
        for (int i = 0; i < 8; ++i) w[t][i] = cw[t * MIXW + c + i];
    for (int strip = blockIdx.x; strip < NTOK / 64; strip += gridDim.x) {
        const int t0 = strip * 64 + sub * 16;
        const bf16_t* pr = p + (size_t)t0 * ldp + c;
        float pp[8], pc[8], pn[8], a[8], b[8];
        if ((t0 & (SEQ - 1)) == 0) {
#pragma unroll
            for (int i = 0; i < 8; ++i) pp[i] = 0.f;
        } else { unpack8(*(const u32x4*)(pr - ldp + MIXW), a); unpack8(*(const u32x4*)(pr - ldp + 2 * MIXW), b);
#pragma unroll
            for (int i = 0; i < 8; ++i) pp[i] = a[i] * b[i]; }
        unpack8(*(const u32x4*)(pr + MIXW), a); unpack8(*(const u32x4*)(pr + 2 * MIXW), b);
#pragma unroll
        for (int i = 0; i < 8; ++i) pc[i] = a[i] * b[i];
#pragma unroll 2
        for (int t = 0; t < 16; ++t) {
            const int tt = t0 + t; const bf16_t* r = pr + (size_t)t * ldp;
            if ((tt & (SEQ - 1)) == SEQ - 1) {
#pragma unroll
                for (int i = 0; i < 8; ++i) pn[i] = 0.f;
            } else { unpack8(*(const u32x4*)(r + ldp + MIXW), a); unpack8(*(const u32x4*)(r + ldp + 2 * MIXW), b);
#pragma unroll
                for (int i = 0; i < 8; ++i) pn[i] = a[i] * b[i]; }
            float gb[8], o[8]; unpack8(*(const u32x4*)r, gb);
#pragma unroll
            for (int i = 0; i < 8; ++i) o[i] = gb[i] * (w[0][i] * pp[i] + w[1][i] * pc[i] + w[2][i] * pn[i]);
            u32x4 ow; ow.x = cvt_pk_bf16(o[0], o[1]); ow.y = cvt_pk_bf16(o[2], o[3]); ow.z = cvt_pk_bf16(o[4], o[5]); ow.w = cvt_pk_bf16(o[6], o[7]);
            *(u32x4*)(mix + (size_t)tt * D + c) = ow;
#pragma unroll
            for (int i = 0; i < 8; ++i) { pp[i] = pc[i]; pc[i] = pn[i]; }
        }
    }
}

__device__ __forceinline__ bf16x8 mk8(u32x2 lo, u32x2 hi) { u32x4 t; t.x = lo.x; t.y = lo.y; t.z = hi.x; t.w = hi.y; return __builtin_bit_cast(bf16x8, t); }
__device__ __forceinline__ f32x4 mfma16(bf16x8 a, bf16x8 b, f32x4 c) { return __builtin_amdgcn_mfma_f32_16x16x32_bf16(a, b, c, 0, 0, 0); }

__device__ __forceinline__ int t5_bucket(int rel) {
    const int n = rel < 0 ? -rel : rel; int b;
    if (n < 8) b = n; else { int lg = 2 + (31 - __clz(n * n)); b = lg > 15 ? 15 : lg; }
    return b + (rel > 0 ? 16 : 0);
}
#ifdef EXPV
__device__ int g_variant_dummy;
#endif
#ifdef ALL_LATE
#define FL_SB
#else
#define FL_SB __builtin_amdgcn_sched_barrier(0)
#endif
template <int MODE>
__device__ __forceinline__ void flash_item(int variant, LAS unsigned char* lds, const bf16_t* Qp, int ldq, const bf16_t* Kp, int ldk, const bf16_t* Vp, int ldv,
                                           int nkeys, int q0, const LAS float* btab, bf16_t* Op, const float* lamp, float lam_init, const float* subln, float outscale) {
    constexpr int EB = MODE ? 8 : 4, KROWB = MODE ? 256 : 128, KPITCH = KROWB + 16, VPITCH = 144, KBYTES = 64 * KPITCH, BUFB = KBYTES + EB * 16 * VPITCH;
    constexpr int KCH = KROWB / 16, NKL = 64 * KCH / 512;
    const int tid = otid(), lane = tid & 63, wid = __builtin_amdgcn_readfirstlane(tid >> 6), l15 = lane & 15, quad = lane >> 4;
    const int sub = MODE ? (wid >> 2) : 0, qrow0 = MODE ? (wid & 3) * 32 : wid * 32;
    bf16x8 Qf[2][2];
#pragma unroll
    for (int qt = 0; qt < 2; ++qt)
#pragma unroll
        for (int ks = 0; ks < 2; ++ks) Qf[qt][ks] = *(const bf16x8*)(Qp + (size_t)(qrow0 + qt * 16 + l15) * ldq + sub * 64 + ks * 32 + quad * 8);
    f32x4 O[2][EB];
#pragma unroll
    for (int qt = 0; qt < 2; ++qt)
#pragma unroll
        for (int eb = 0; eb < EB; ++eb) O[qt][eb] = (f32x4){0.f, 0.f, 0.f, 0.f};
    float lrun[2] = {0.f, 0.f}, mref[2];
    u32x4 kreg[NKL], vreg[2];
    const int veg = (EB == 8) ? ((wid & 3) * 4 + (lane & 3)) : ((wid & 1) * 4 + (lane & 3));
    const int vpair = (EB == 8) ? ((wid >> 2) * 16 + (lane >> 2)) : ((wid >> 1) * 16 + (lane >> 2));
    const bool vact = (EB == 8) || (wid < 4);
    auto gload = [&](int k0) {
#pragma unroll
        for (int i = 0; i < NKL; ++i) { const int c = tid + i * 512, chunk = c % KCH, key = c / KCH;
            kreg[i] = *(const u32x4*)(Kp + (size_t)(k0 + key) * ldk + chunk * 8); }
        if (vact) { vreg[0] = *(const u32x4*)(Vp + (size_t)(k0 + 2 * vpair) * ldv + veg * 8); vreg[1] = *(const u32x4*)(Vp + (size_t)(k0 + 2 * vpair + 1) * ldv + veg * 8); }
    };
    auto lstore = [&](int buf) {
        LAS unsigned char* kb = lds + buf * BUFB; LAS unsigned char* vb = kb + KBYTES;
#pragma unroll
        for (int i = 0; i < NKL; ++i) { const int c = tid + i * 512, chunk = c % KCH, key = c / KCH;
            *(LAS u32x4*)(kb + key * KPITCH + chunk * 16) = kreg[i]; }
        if (vact) {
            const unsigned a[4] = {vreg[0].x, vreg[0].y, vreg[0].z, vreg[0].w}, b[4] = {vreg[1].x, vreg[1].y, vreg[1].z, vreg[1].w};
            const int pl = vpair & 15, vdp = (vpair & 16) + 4 * ((pl & 7) >> 1) + 2 * (pl >> 3) + (pl & 1);
#pragma unroll
            for (int i = 0; i < 4; ++i) {
                *(LAS unsigned*)(vb + (veg * 8 + 2 * i) * VPITCH + vdp * 4) = (a[i] & 0xffffu) | (b[i] << 16);
                *(LAS unsigned*)(vb + (veg * 8 + 2 * i + 1) * VPITCH + vdp * 4) = (a[i] >> 16) | (b[i] & 0xffff0000u);
            }
        }
    };
    const int nt = nkeys / 64;
    gload(0); lstore(0); gload(64); lstore(1); __syncthreads();
    const int qlo = q0 + qrow0;
    {
        float mx0 = -INFINITY, mx1 = -INFINITY;
#pragma unroll
        for (int kb = 0; kb < 4; ++kb) {
            f32x4 S0 = (f32x4){0.f, 0.f, 0.f, 0.f}, S1 = (f32x4){0.f, 0.f, 0.f, 0.f};
#pragma unroll
            for (int ks = 0; ks < 2; ++ks) {
                const bf16x8 a = *(const LAS bf16x8*)(lds + (kb * 16 + l15) * KPITCH + sub * 128 + ks * 64 + quad * 16);
                S0 = mfma16(a, Qf[0][ks], S0); S1 = mfma16(a, Qf[1][ks], S1);
            }
            mx0 = fmaxf(mx0, fmaxf(fmaxf(S0[0], S0[1]), fmaxf(S0[2], S0[3]))); mx1 = fmaxf(mx1, fmaxf(fmaxf(S1[0], S1[1]), fmaxf(S1[2], S1[3])));
        }
        mx0 = fmaxf(mx0, __shfl_xor(mx0, 16)); mx0 = fmaxf(mx0, __shfl_xor(mx0, 32)); mx1 = fmaxf(mx1, __shfl_xor(mx1, 16)); mx1 = fmaxf(mx1, __shfl_xor(mx1, 32));
        mref[0] = mx0; mref[1] = mx1;
    }
    bf16x8 Pf[2][2];
    auto pv = [&](const LAS unsigned char* vbuf) {
#pragma unroll
        for (int g = 0; g < 2; ++g) {
            bf16x8 vf[EB];
#pragma unroll
            for (int eb = 0; eb < EB; ++eb) vf[eb] = *(const LAS bf16x8*)(vbuf + (eb * 16 + l15) * VPITCH + (32 * g + 8 * quad) * 2);
#pragma unroll
            for (int eb = 0; eb < EB; ++eb) { O[0][eb] = mfma16(vf[eb], Pf[0][g], O[0][eb]); O[1][eb] = mfma16(vf[eb], Pf[1][g], O[1][eb]); }
        }
    };
    auto sphase = [&](const LAS unsigned char* kbuf, int k0) {
        bool bnear = false; float bconst = 0.f;
        if (MODE) { if (k0 - (qlo + 31) >= 91) bconst = btab[511]; else if (qlo - (k0 + 63) >= 91) bconst = btab[0]; else bnear = true; }
        const float sh0 = bconst - mref[0], sh1 = bconst - mref[1];
        bf16x8 kf[4][2];
#pragma unroll
        for (int kb = 0; kb < 4; ++kb)
#pragma unroll
            for (int ks = 0; ks < 2; ++ks) kf[kb][ks] = *(const LAS bf16x8*)(kbuf + (kb * 16 + l15) * KPITCH + sub * 128 + ks * 64 + quad * 16);
        f32x4 S[2][4];
#pragma unroll
        for (int kb = 0; kb < 4; ++kb) { S[0][kb] = (f32x4){sh0, sh0, sh0, sh0}; S[1][kb] = (f32x4){sh1, sh1, sh1, sh1}; }
        if (MODE && bnear) {
#pragma unroll
            for (int kb = 0; kb < 4; ++kb) { const LAS float* bq = btab + (k0 + kb * 16 + quad * 4 - (qlo + l15) + 256);
#pragma unroll
                for (int j = 0; j < 4; ++j) { S[0][kb][j] += bq[j]; S[1][kb][j] += bq[j - 16]; } }
        }
#pragma unroll
        for (int kb = 0; kb < 4; ++kb)
#pragma unroll
            for (int ks = 0; ks < 2; ++ks) { S[0][kb] = mfma16(kf[kb][ks], Qf[0][ks], S[0][kb]); S[1][kb] = mfma16(kf[kb][ks], Qf[1][ks], S[1][kb]); }
#pragma unroll
        for (int qt = 0; qt < 2; ++qt) {
            float ls = 0.f;
#pragma unroll
            for (int kb = 0; kb < 4; ++kb) {
                S[qt][kb][0] = fast_exp2(S[qt][kb][0]); S[qt][kb][1] = fast_exp2(S[qt][kb][1]); S[qt][kb][2] = fast_exp2(S[qt][kb][2]); S[qt][kb][3] = fast_exp2(S[qt][kb][3]);
                ls += (S[qt][kb][0] + S[qt][kb][1]) + (S[qt][kb][2] + S[qt][kb][3]);
            }
            lrun[qt] += ls;
#pragma unroll
            for (int g = 0; g < 2; ++g) { u32x4 w; w.x = cvt_pk_bf16(S[qt][2 * g][0], S[qt][2 * g][1]); w.y = cvt_pk_bf16(S[qt][2 * g][2], S[qt][2 * g][3]);
                w.z = cvt_pk_bf16(S[qt][2 * g + 1][0], S[qt][2 * g + 1][1]); w.w = cvt_pk_bf16(S[qt][2 * g + 1][2], S[qt][2 * g + 1][3]);
                Pf[qt][g] = __builtin_bit_cast(bf16x8, w); }
        }
    };
    for (int t = 0; t < nt; t += 2) {
        const int b0 = t & 3, b1 = (t + 1) & 3, b2 = (t + 2) & 3, b3 = (t + 3) & 3;
        const bool more = t + 2 < nt;
        if (more) gload((t + 2) * 64);
        sphase(lds + b0 * BUFB, t * 64);
        pv(lds + b0 * BUFB + KBYTES);
        if (more) { lstore(b2); gload((t + 3) * 64); }
        sphase(lds + b1 * BUFB, (t + 1) * 64);
        pv(lds + b1 * BUFB + KBYTES);
        if (more) lstore(b3);
        __syncthreads();
    }
    float inv[2];
#pragma unroll
    for (int qt = 0; qt < 2; ++qt) { float l = lrun[qt]; l += __shfl_xor(l, 16); l += __shfl_xor(l, 32); inv[qt] = 1.0f / l; }
    if (MODE == 0) {
#pragma unroll
        for (int qt = 0; qt < 2; ++qt) { bf16_t* orow = Op + (size_t)(qrow0 + qt * 16 + l15) * D + quad * 4;
#pragma unroll
            for (int eb = 0; eb < EB; ++eb) { const f32x4 y = O[qt][eb] * inv[qt];
                u32x2 w; w.x = cvt_pk_bf16(y.x, y.y); w.y = cvt_pk_bf16(y.z, y.w); *(u32x2*)(orow + eb * 16) = w; } }
    } else {
        LAS f32x4* X = (LAS f32x4*)lds + (size_t)(wid & 3) * (2 * EB * 64) + lane;
        if (sub == 1) {
            float s01 = 0.f, s23 = 0.f;
            for (int i = 0; i < 64; ++i) { s01 += lamp[i] * lamp[64 + i]; s23 += lamp[128 + i] * lamp[192 + i]; }
            const float lam = expf(s01) - expf(s23) + lam_init;
#pragma unroll
            for (int qt = 0; qt < 2; ++qt)
#pragma unroll
                for (int eb = 0; eb < EB; ++eb) X[(qt * EB + eb) * 64] = O[qt][eb] * (lam * inv[qt]);
        }
        __syncthreads();
        if (sub == 0) {
#pragma unroll
            for (int qt = 0; qt < 2; ++qt) {
                f32x4 dv[EB]; float ss = 0.f;
#pragma unroll
#ifdef T_NOX
                for (int eb = 0; eb < EB; ++eb) { dv[eb] = O[qt][eb] * inv[qt];
#else
                for (int eb = 0; eb < EB; ++eb) { dv[eb] = O[qt][eb] * inv[qt] - X[(qt * EB + eb) * 64];
#endif
                    ss += (dv[eb].x * dv[eb].x + dv[eb].y * dv[eb].y) + (dv[eb].z * dv[eb].z + dv[eb].w * dv[eb].w); }
                ss += __shfl_xor(ss, 16); ss += __shfl_xor(ss, 32);
                const float r = outscale / sqrtf(ss * (1.0f / (EB * 16)) + LN_EPS);
                bf16_t* orow = Op + (size_t)(qrow0 + qt * 16 + l15) * D + quad * 4;
#pragma unroll
                for (int eb = 0; eb < EB; ++eb) { const f32x4 gsl = *(const f32x4*)(subln + eb * 16 + quad * 4); const f32x4 y = dv[eb] * r * gsl;
                    u32x2 w; w.x = cvt_pk_bf16(y.x, y.y); w.y = cvt_pk_bf16(y.z, y.w); *(u32x2*)(orow + eb * 16) = w; }
            }
        }
        __syncthreads();
    }
}

__device__ __forceinline__ void diffattn_phase(const Params& P, LAS unsigned char* lds, const bf16_t* p, bf16_t* mix, int layer, int variant = 0) {
    const int jj = layer / 3;
    const float* lp = P.attn_lambda + jj * 256;
    const float lam_init = layer == 0 ? 0.200000000f : (layer == 1 ? 0.355509068f : (layer == 2 ? 0.470713018f : 0.556058204f));
    LAS float* btab = (LAS float*)(lds + 4 * (64 * 272 + 128 * 144));
    int cur_h = -1;
    for (int item = blockIdx.x; item < 4 * 6 * 64; item += gridDim.x) {
        const int bh = item >> 6, qb = item & 63, b = bh / 6, h = bh % 6;
        if (h != cur_h) { __syncthreads();
            for (int i = otid(); i < 512; i += 512) btab[i] = P.rel_bias[t5_bucket(i - 256) * 6 + h] * LOG2E;
            cur_h = h; __syncthreads(); }
        const size_t tok0 = (size_t)b * SEQ + qb * 128;
        flash_item<1>(variant, lds, p + tok0 * 2560 + h * 128, 2560, p + (size_t)b * SEQ * 2560 + MIXW + h * 128, 2560, p + (size_t)b * SEQ * 2560 + 2 * MIXW + h * 128, 2560,
                      SEQ, qb * 128, btab, mix + tok0 * D + h * 128, lp, lam_init, P.attn_subln + jj * 128, 1.0f - lam_init);
    }
}
__device__ __forceinline__ void memattn_phase(const Params& P, LAS unsigned char* lds, const bf16_t* p, int ldp, int xq0, bf16_t* mix, int layer, int first = 0, int stride = 0) {
    const bf16_t* kvm = (const bf16_t*)(P.ws + WS_KVM);
    if (stride == 0) { first = blockIdx.x; stride = gridDim.x; }
    for (int item = first; item < 128 * 4; item += stride) {
        const int h = item & 3, qb = item >> 2; const size_t tok0 = (size_t)qb * 256; const int b = qb >> 5;
        const bf16_t* kp = kvm + (size_t)b * 256 * 2048 + layer * 512 + h * 64;
        flash_item<0>(0, lds, p + tok0 * ldp + xq0 + h * 64, ldp, kp, 2048, kp + 256, 2048, 256, 0, nullptr, mix + tok0 * D + MIXW + h * 64, nullptr, 0.f, nullptr, 1.0f);
    }
}

__device__ __forceinline__ void hgrn_prep(const Params& P, bf16_t* p, bf16_t* QF, float* elast, int layer) {
    const size_t total = (size_t)4 * 128 * 384;
    for (size_t it = (size_t)blockIdx.x * 512 + otid(); it < total; it += (size_t)gridDim.x * 512) {
        const int cp = (int)(it % 384), chunk = (int)((it / 384) % 128), b = (int)(it / (384 * 128));
        const int c = cp * 2;
        float lb[2][2];
#pragma unroll
        for (int d = 0; d < 2; ++d)
#pragma unroll
            for (int e = 0; e < 2; ++e) { float den = 0.f, num = 0.f;
                for (int i = 0; i < 4; ++i) { const float ev = expf(P.hgrn_lb[(size_t)i * 2 * MIXW + d * MIXW + c + e]); den += ev; if (i >= 1 && i <= layer) num += ev; }
                lb[d][e] = num / den; }
        bf16_t* base = p + ((size_t)b * SEQ + chunk * 64) * 4096 + c;
        bf16_t* qf = QF + ((size_t)b * SEQ + chunk * 64) * MIXW + c;
        const float QS = 0.08838834764831845f;
        float e0 = 1.f, e1 = 1.f;
        for (int t = 0; t < 64; ++t) {
            const unsigned qw = *(const unsigned*)(base + (size_t)t * 4096), zw = *(const unsigned*)(base + (size_t)t * 4096 + 3 * MIXW);
            const float q0 = bflo(qw), q1 = bfhi(qw), z0 = bflo(zw), z1 = bfhi(zw);
            const float sg0 = fast_sigmoid(z0), sg1 = fast_sigmoid(z1);
            e0 *= lb[0][0] + (1.f - lb[0][0]) * sg0; e1 *= lb[0][1] + (1.f - lb[0][1]) * sg1;
            *(unsigned*)(qf + (size_t)t * MIXW) = cvt_pk_bf16(fast_silu(q0) * QS * e0, fast_silu(q1) * QS * e1);
            *(unsigned*)(base + (size_t)t * 4096 + 3 * MIXW) = cvt_pk_bf16((1.f - lb[0][0]) * (1.f - sg0) * __builtin_amdgcn_rcpf(e0), (1.f - lb[0][1]) * (1.f - sg1) * __builtin_amdgcn_rcpf(e1));
        }
        { float* el = elast + ((size_t)(0 * 4 + b) * 128 + chunk) * MIXW + c; el[0] = e0; el[1] = e1; }
        e0 = 1.f; e1 = 1.f;
        for (int t = 63; t >= 0; --t) {
            const unsigned qw = *(const unsigned*)(base + (size_t)t * 4096), zw = *(const unsigned*)(base + (size_t)t * 4096 + 4 * MIXW);
            const float q0 = bflo(qw), q1 = bfhi(qw), z0 = bflo(zw), z1 = bfhi(zw);
            const float sg0 = fast_sigmoid(z0), sg1 = fast_sigmoid(z1);
            e0 *= lb[1][0] + (1.f - lb[1][0]) * sg0; e1 *= lb[1][1] + (1.f - lb[1][1]) * sg1;
            *(unsigned*)(base + (size_t)t * 4096) = cvt_pk_bf16(fast_silu(q0) * QS * e0, fast_silu(q1) * QS * e1);
            *(unsigned*)(base + (size_t)t * 4096 + 4 * MIXW) = cvt_pk_bf16((1.f - lb[1][0]) * (1.f - sg0) * __builtin_amdgcn_rcpf(e0), (1.f - lb[1][1]) * (1.f - sg1) * __builtin_amdgcn_rcpf(e1));
        }
        { float* el = elast + ((size_t)(1 * 4 + b) * 128 + chunk) * MIXW + c; el[0] = e0; el[1] = e1; }
    }
}

__device__ __forceinline__ void hgrn_scan(const Params& P, LAS unsigned char* lds, const bf16_t* p, const bf16_t* QF, const float* elast, bf16_t* mix, bf16_t* OB) {
    constexpr int RP = 272, TP = 136;
    constexpr int OQ = 0, OK = 64 * RP, OKT = 2 * 64 * RP, OVT = OKT + 128 * TP, INB = OVT + 32 * TP;
    constexpr int SBB = 32 * RP, OSB = 0, INB0 = 2 * SBB;
    const int tid = otid(), lane = tid & 63, wid = tid >> 6, l15 = lane & 15, quad = lane >> 4;
    const int keg = (wid & 3) * 4 + (lane & 3), kpair = (wid >> 2) * 16 + (lane >> 2);
    const int veg = lane & 3, vpair = wid * 16 + (lane >> 2); const bool vact = wid < 2;
    const int vb = wid & 1, tb = wid >> 1;
    for (int item = blockIdx.x; item < 192; item += gridDim.x) {
        const int dir = item / 96, r = item % 96, b = r / 24, h = (r % 24) >> 2, vs = r & 3;
        const bf16_t* qsrc = dir == 0 ? QF + (size_t)b * SEQ * MIXW + h * 128 : p + (size_t)b * SEQ * 4096 + h * 128;
        const int ldqs = dir == 0 ? MIXW : 4096;
        const bf16_t* ksrc = p + (size_t)b * SEQ * 4096 + (3 + dir) * MIXW + h * 128;
        const bf16_t* vsrc = p + (size_t)b * SEQ * 4096 + MIXW + h * 128 + vs * 32;
        const float* elp = elast + (size_t)(dir * 4 + b) * 128 * MIXW + h * 128 + wid * 16 + l15;
        bf16_t* osrc = dir == 0 ? mix + (size_t)b * SEQ * D + h * 128 + vs * 32 : OB + (size_t)b * SEQ * MIXW + h * 128 + vs * 32;
        const int ldo = dir == 0 ? D : MIXW;
        u32x4 qreg[2], kreg[2], vreg[2]; float elreg = 0.f;
        auto gload = [&](int chunk) {
            const size_t t0 = (size_t)chunk * 64;
#pragma unroll
            for (int i = 0; i < 2; ++i) { const int c = tid + i * 512, ch = c & 15, row = c >> 4; qreg[i] = *(const u32x4*)(qsrc + (t0 + row) * ldqs + ch * 8); }
            kreg[0] = *(const u32x4*)(ksrc + (t0 + 2 * kpair) * 4096 + keg * 8); kreg[1] = *(const u32x4*)(ksrc + (t0 + 2 * kpair + 1) * 4096 + keg * 8);
            if (vact) { vreg[0] = *(const u32x4*)(vsrc + (t0 + 2 * vpair) * 4096 + veg * 8); vreg[1] = *(const u32x4*)(vsrc + (t0 + 2 * vpair + 1) * 4096 + veg * 8); }
            elreg = elp[(size_t)chunk * MIXW];
        };
        auto lstore = [&](int buf) {
            LAS unsigned char* bb = lds + INB0 + buf * INB;
#pragma unroll
            for (int i = 0; i < 2; ++i) { const int c = tid + i * 512, ch = c & 15, row = c >> 4; *(LAS u32x4*)(bb + OQ + row * RP + ch * 16) = qreg[i]; }
            *(LAS u32x4*)(bb + OK + (2 * kpair) * RP + keg * 16) = kreg[0]; *(LAS u32x4*)(bb + OK + (2 * kpair + 1) * RP + keg * 16) = kreg[1];
            { const unsigned a[4] = {kreg[0].x, kreg[0].y, kreg[0].z, kreg[0].w}, c2[4] = {kreg[1].x, kreg[1].y, kreg[1].z, kreg[1].w};
#pragma unroll
              for (int i = 0; i < 4; ++i) { *(LAS unsigned*)(bb + OKT + (keg * 8 + 2 * i) * TP + kpair * 4) = (a[i] & 0xffffu) | (c2[i] << 16);
                  *(LAS unsigned*)(bb + OKT + (keg * 8 + 2 * i + 1) * TP + kpair * 4) = (a[i] >> 16) | (c2[i] & 0xffff0000u); } }
            if (vact) { const unsigned a[4] = {vreg[0].x, vreg[0].y, vreg[0].z, vreg[0].w}, c2[4] = {vreg[1].x, vreg[1].y, vreg[1].z, vreg[1].w};
#pragma unroll
              for (int i = 0; i < 4; ++i) { *(LAS unsigned*)(bb + OVT + (veg * 8 + 2 * i) * TP + vpair * 4) = (a[i] & 0xffffu) | (c2[i] << 16);
                  *(LAS unsigned*)(bb + OVT + (veg * 8 + 2 * i + 1) * TP + vpair * 4) = (a[i] >> 16) | (c2[i] & 0xffff0000u); } }
        };
        for (int i = tid; i < SBB / 4; i += 512) *(LAS unsigned*)(lds + OSB + i * 4) = 0u;
        f32x4 Sacc[2] = {(f32x4){0.f, 0.f, 0.f, 0.f}, (f32x4){0.f, 0.f, 0.f, 0.f}};
        gload(dir == 0 ? 0 : 127); lstore(0); float elcur = elreg; __syncthreads();
        for (int step = 0; step < 128; ++step) {
            const int chunk = dir == 0 ? step : 127 - step;
            LAS unsigned char* bb = lds + INB0 + (step & 1) * INB; LAS unsigned char* sbc = lds + OSB + (step & 1) * SBB; LAS unsigned char* sbn = lds + OSB + ((step + 1) & 1) * SBB;
            if (step + 1 < 128) gload(dir == 0 ? step + 1 : 126 - step);
            bf16x8 Qfr[4];
#pragma unroll
            for (int ks = 0; ks < 4; ++ks) Qfr[ks] = *(const LAS bf16x8*)(bb + OQ + (tb * 16 + l15) * RP + ks * 64 + quad * 16);
            f32x4 oacc = (f32x4){0.f, 0.f, 0.f, 0.f};
#pragma unroll
#ifndef T_NOSTATE
            for (int ks = 0; ks < 4; ++ks) { const bf16x8 a = *(const LAS bf16x8*)(sbc + (vb * 16 + l15) * RP + ks * 64 + quad * 16); oacc = mfma16(a, Qfr[ks], oacc); }
#endif
            f32x4 A4[4];
#pragma unroll
            for (int sb = 0; sb < 4; ++sb) { A4[sb] = (f32x4){0.f, 0.f, 0.f, 0.f};
                const bool need = dir == 0 ? (sb <= tb) : (sb >= tb);
                if (need) {
#pragma unroll
                    for (int ks = 0; ks < 4; ++ks) { const bf16x8 a = *(const LAS bf16x8*)(bb + OK + (sb * 16 + l15) * RP + ks * 64 + quad * 16); A4[sb] = mfma16(a, Qfr[ks], A4[sb]); }
                    if (sb == tb) {
#pragma unroll
                        for (int j = 0; j < 4; ++j) { const int s = quad * 4 + j; const bool keep = dir == 0 ? (s <= l15) : (s >= l15); A4[sb][j] = keep ? A4[sb][j] : 0.f; }
                    }
                } }
#ifndef T_NOINTRA
#pragma unroll
            for (int g = 0; g < 2; ++g) { u32x4 w; w.x = cvt_pk_bf16(A4[2 * g][0], A4[2 * g][1]); w.y = cvt_pk_bf16(A4[2 * g][2], A4[2 * g][3]);
                w.z = cvt_pk_bf16(A4[2 * g + 1][0], A4[2 * g + 1][1]); w.w = cvt_pk_bf16(A4[2 * g + 1][2], A4[2 * g + 1][3]);
                const LAS unsigned char* vp = bb + OVT + (vb * 16 + l15) * TP + (32 * g + 4 * quad) * 2;
                const bf16x8 a = mk8(*(const LAS u32x2*)vp, *(const LAS u32x2*)(vp + 32));
                oacc = mfma16(a, __builtin_bit_cast(bf16x8, w), oacc); }
#endif
            { u32x2 w; w.x = cvt_pk_bf16(oacc[0], oacc[1]); w.y = cvt_pk_bf16(oacc[2], oacc[3]);
              *(u32x2*)(osrc + ((size_t)chunk * 64 + tb * 16 + l15) * ldo + vb * 16 + quad * 4) = w; }
#pragma unroll
            for (int v2 = 0; v2 < 2; ++v2) {
#pragma unroll
                for (int g = 0; g < 2; ++g) { const LAS unsigned char* vp = bb + OVT + (v2 * 16 + l15) * TP + (32 * g + 8 * quad) * 2;
                    const LAS unsigned char* kp = bb + OKT + (wid * 16 + l15) * TP + (32 * g + 8 * quad) * 2;
                    Sacc[v2] = mfma16(mk8(*(const LAS u32x2*)vp, *(const LAS u32x2*)(vp + 8)), mk8(*(const LAS u32x2*)kp, *(const LAS u32x2*)(kp + 8)), Sacc[v2]); }
                Sacc[v2] = Sacc[v2] * elcur;
#pragma unroll
                for (int j = 0; j < 4; ++j) *(LAS unsigned short*)(sbn + (v2 * 16 + quad * 4 + j) * RP + (wid * 16 + l15) * 2) = (unsigned short)(cvt_pk_bf16(Sacc[v2][j], 0.f) & 0xffffu);
            }
            if (step + 1 < 128) { lstore((step + 1) & 1); elcur = elreg; }
            __syncthreads();
        }
    }
}
__device__ __forceinline__ void hgrn_combine(const Params& P, const bf16_t* p, bf16_t* mix, const bf16_t* OB) {
    const int lane = otid() & 63, wid = otid() >> 6, grp = lane >> 4, l15 = lane & 15;
    const size_t total = (size_t)NTOK * 6 / 4;
    for (size_t it = (size_t)blockIdx.x * 8 + wid; it < total; it += (size_t)gridDim.x * 8) {
        const size_t pair = it * 4 + grp; const size_t tok = pair / 6; const int h = (int)(pair % 6); const int c = h * 128 + l15 * 8;
        float a[8], bq[8], gg[8], o[8];
        unpack8(*(const u32x4*)(mix + tok * D + c), a); unpack8(*(const u32x4*)(OB + tok * MIXW + c), bq); unpack8(*(const u32x4*)(p + tok * 4096 + 2 * MIXW + c), gg);
        float ss = 0.f;
#pragma unroll
        for (int i = 0; i < 8; ++i) { o[i] = a[i] + bq[i]; ss += o[i] * o[i]; }
        ss += __shfl_xor(ss, 1); ss += __shfl_xor(ss, 2); ss += __shfl_xor(ss, 4); ss += __shfl_xor(ss, 8);
        const float r = 1.0f / sqrtf(ss * (1.0f / 128.f) + LN_EPS);
        const f32x4 w0 = *(const f32x4*)(P.hgrn_norm + c), w1 = *(const f32x4*)(P.hgrn_norm + c + 4);
        const float wn[8] = {w0.x, w0.y, w0.z, w0.w, w1.x, w1.y, w1.z, w1.w};
#pragma unroll
        for (int i = 0; i < 8; ++i) o[i] = o[i] * r * wn[i] * fast_silu(gg[i]);
        u32x4 ow; ow.x = cvt_pk_bf16(o[0], o[1]); ow.y = cvt_pk_bf16(o[2], o[3]); ow.z = cvt_pk_bf16(o[4], o[5]); ow.w = cvt_pk_bf16(o[6], o[7]);
        *(u32x4*)(mix + tok * D + c) = ow;
    }
}


__device__ __forceinline__ void gsync(cg::grid_group& grid) {
#ifdef GSYNC_HEAVY
    asm volatile("s_waitcnt vmcnt(0) lgkmcnt(0)" ::: "memory");
    __syncthreads();
    if (otid() < 64) { __builtin_amdgcn_fence(__ATOMIC_RELEASE, "agent"); asm volatile("s_waitcnt vmcnt(0)" ::: "memory"); }
    __syncthreads();
    grid.sync();
    __builtin_amdgcn_fence(__ATOMIC_ACQUIRE, "agent");
    asm volatile("s_waitcnt vmcnt(0)" ::: "memory");
    __syncthreads();
#else
    asm volatile("s_waitcnt vmcnt(0) lgkmcnt(0)" ::: "memory");
    grid.sync();
#endif
}
#ifdef DBG_STOP
__device__ __forceinline__ void dbg_dump_bf16(float* out, const bf16_t* src, int ld) {
    for (size_t i = (size_t)blockIdx.x * 512 + otid(); i < (size_t)NTOK * D; i += (size_t)gridDim.x * 512) { const size_t t = i / D, c = i % D; float v = bf2f(src[t * ld + c]); out[i] = (v == v && fabsf(v) < 1e30f) ? v : 12345.f; }
}
__device__ __forceinline__ void dbg_san(float* out) {
    for (size_t i = (size_t)blockIdx.x * 512 + otid(); i < (size_t)NTOK * D; i += (size_t)gridDim.x * 512) { float v = out[i]; out[i] = (v == v && fabsf(v) < 1e30f) ? v : 12345.f; }
}
#define DBG_AT(n, code) if (DBG_STOP == (n)) { gsync(grid); code; return; }
#else
#define DBG_AT(n, code)
#endif
#ifdef UNFUSED_GATE
constexpr int NPH = 1 + 4 * 12 + 2;
#else
constexpr int NPH = 1 + 4 * 8 + 2;
#endif
__global__ void __launch_bounds__(512) mega_fwd(Params P, int lo, int hi, int variant) {
    extern __shared__ __attribute__((aligned(16))) unsigned char shm[];
    LAS unsigned char* lds = (LAS unsigned char*)shm;
    cg::grid_group grid = cg::this_grid();
    unsigned char* ws = P.ws;
    bf16_t* Wt_in = (bf16_t*)(ws + WS_WIN); bf16_t* Wt_o = (bf16_t*)(ws + WS_WO); bf16_t* Wt_up = (bf16_t*)(ws + WS_WUP); bf16_t* Wt_dn = (bf16_t*)(ws + WS_WDN);
    bf16_t* xb = (bf16_t*)(ws + WS_XB); bf16_t* pbuf = (bf16_t*)(ws + WS_BIG); bf16_t* mix = (bf16_t*)(ws + WS_BIG + BIG_MIX);
    bf16_t* gbuf = (bf16_t*)(ws + WS_BIG); bf16_t* ubuf = (bf16_t*)(ws + WS_BIG + BIG_U); bf16_t* OB = (bf16_t*)(ws + WS_OB);
    float* elast = (float*)(ws + WS_ELAST); float* lnst = (float*)(ws + WS_LNST);
#ifdef TIMING_DUMMY
    if (lo < 0) {
        float* sf = (float*)(ws + WS_BIG + BIG_U); bf16_t* sb = mix;
        if (variant == 10) ln_phase(sf, sb, P.ln_gain, P.ln_bias, lnst, false);
        else if (variant == 11) hgrn_prep(P, pbuf, xb, elast, 1);
        else if (variant == 12) hgrn_combine(P, pbuf, mix, OB);
        else if (variant == 13) memattn_phase(P, lds, pbuf, 2560, 2304, mix, 0);
        else if (variant == 14) convert_layer(P, 1, lds);
        else if (variant == 15) { EpiResid E; E.io = sf; E.xin = P.x; E.stats = nullptr; E.lg = nullptr; E.lb = nullptr; run_gemm(lds, mix, Wt_o, NTOK, D, D, E); }
        else if (variant == 16) { EpiResid E; E.io = sf; E.xin = P.x; E.stats = nullptr; E.lg = nullptr; E.lb = nullptr; run_gemm(lds, gbuf, Wt_dn, NTOK, D, DFF, E); }
        else if (variant == 17) shortconv_phase(pbuf, 2560, mix, P.conv_w);
        else if (variant == 18) { convert_prologue(P, lds); }
        return;
    }
#endif
    int ph = 0;
#define SEG(...) { if (ph >= lo && ph < hi) { __VA_ARGS__; if (ph + 1 < hi) gsync(grid); } ++ph; }
    SEG(convert_prologue(P, lds); convert_layer(P, 0, lds))
    for (int layer = 0; layer < 4; ++layer) {
        const int kind = layer % 3; const int NIN = kind == 1 ? 4096 : 2560;
        SEG(if (layer == 0) { EpiBf16P E; E.O = (bf16_t*)(ws + WS_KVM); E.ldc = 2048; run_gemm(lds, (const bf16_t*)(ws + WS_MEMB), (const bf16_t*)(ws + WS_WKV), 1024, 2048, D, E); }
            { EpiBf16P E; E.O = pbuf; E.ldc = NIN; run_gemm(lds, xb, Wt_in, NTOK, NIN, D, E); })
        if (kind == 1) {
            SEG(hgrn_prep(P, pbuf, xb, elast, layer))
            SEG(if ((int)gridDim.x > 192 && (int)blockIdx.x >= 192) memattn_phase(P, lds, pbuf, NIN, NIN - 256, mix, layer, (int)blockIdx.x - 192, (int)gridDim.x - 192);
                else hgrn_scan(P, lds, pbuf, xb, elast, mix, OB))
        }
        SEG(if (kind == 0) diffattn_phase(P, lds, pbuf, mix, layer, variant);
            else if (kind == 2) shortconv_phase(pbuf, 2560, mix, P.conv_w + (size_t)(layer / 3) * 3 * MIXW);
            else hgrn_combine(P, pbuf, mix, OB);
            __syncthreads();
            if (kind != 1 || (int)gridDim.x <= 192) memattn_phase(P, lds, pbuf, NIN, NIN - 256, mix, layer))
        SEG({ EpiResid E; E.io = P.out; E.xin = layer == 0 ? P.x : P.out; E.stats = layer == 0 ? nullptr : lnst; E.lg = P.ln_gain + (size_t)(layer == 0 ? 0 : layer - 1) * 2 * D + D; E.lb = P.ln_bias + (size_t)(layer == 0 ? 0 : layer - 1) * 2 * D + D;
              run_gemm(lds, mix, Wt_o, NTOK, D, D, E); })
        SEG(ln_phase(P.out, xb, P.ln_gain + (size_t)layer * 2 * D, P.ln_bias + (size_t)layer * 2 * D, lnst, false))
#ifdef UNFUSED_GATE
        for (int part = 0; part < 3; ++part) {
            const int tile0 = part * 8, ntile = part < 2 ? 8 : 6;
            SEG({ EpiBf16P E; E.O = ubuf; E.ldc = ntile * 256; run_gemm(lds, xb, Wt_up + (size_t)tile0 * 256 * D, NTOK, ntile * 256, D, E); })
            SEG(gate_phase(ubuf, ntile * 256, tile0, ntile, gbuf, P.ffn_conv + (size_t)layer * 3 * 2 * DFF))
        }
#else
        SEG({ EpiGate E; E.g = gbuf; E.edge = (float*)ubuf; E.cw = P.ffn_conv + (size_t)layer * 3 * 2 * DFF; E.xl = lds + 131072; run_gemm(lds, xb, Wt_up, NTOK, 2 * DFF, D, E); })
        SEG(gate_fixup((const float*)ubuf, gbuf, P.ffn_conv + (size_t)layer * 3 * 2 * DFF))
#endif
        SEG({ EpiResid E; E.io = P.out; E.xin = P.out; E.stats = lnst; E.lg = P.ln_gain + (size_t)layer * 2 * D; E.lb = P.ln_bias + (size_t)layer * 2 * D; run_gemm(lds, gbuf, Wt_dn, NTOK, D, DFF, E); })
        SEG(ln_phase(P.out, xb, P.ln_gain + (size_t)layer * 2 * D + D, P.ln_bias + (size_t)layer * 2 * D + D, lnst, layer == 3);
            if (layer + 1 < 4) convert_layer(P, layer + 1, lds))
    }
#undef SEG
}


#ifdef DBG_LAST
__global__ void dbg_dump_k(Params P, int which) {
    float* out = P.out;
    for (size_t i = (size_t)blockIdx.x * blockDim.x + threadIdx.x; i < (size_t)NTOK * D; i += (size_t)gridDim.x * blockDim.x) {
        const size_t t = i / D, c = i % D; float v;
        if (which == 0) v = out[i];
        else if (which == 1) v = bf2f(((const bf16_t*)(P.ws + WS_XB))[i]);
        else if (which == 2) v = bf2f(((const bf16_t*)(P.ws + WS_BIG))[t * 2560 + c]);
        else if (which == 3) v = bf2f(((const bf16_t*)(P.ws + WS_BIG))[t * 4096 + c]);
        else if (which == 4) v = bf2f(((const bf16_t*)(P.ws + WS_BIG + BIG_MIX))[i]);
        else if (which == 5) v = bf2f(((const bf16_t*)(P.ws + WS_WIN))[t * 128 + c]);
        else if (which == 6) v = bf2f(((const bf16_t*)(P.ws + WS_BIG))[t * 4096 + 2304 + c]);
        else if (which == 12) v = bf2f(((const bf16_t*)(P.ws + WS_BIG + BIG_MIX))[t * 1024 + (c % 768)]);
        else if (which == 13) v = bf2f(((const bf16_t*)(P.ws + WS_BIG + BIG_MIX))[t * 1024 + 768 + (c % 256)]);
        else if (which == 8) v = bf2f(((const bf16_t*)(P.ws + WS_BIG))[t * 2560 + 1024 + c]);
        else if (which == 9) v = bf2f(((const bf16_t*)(P.ws + WS_BIG))[t * 2560 + 1536 + c]);
        else if (which == 10) v = bf2f(((const bf16_t*)(P.ws + WS_KVM))[(t % 1024) * 2048 + c]);
        else if (which == 11) v = bf2f(((const bf16_t*)(P.ws + WS_KVM))[(t % 1024) * 2048 + 1024 + c]);
        else v = bf2f(((const bf16_t*)(P.ws + WS_OB))[t * 768 + (c % 768)]);
        out[i] = (v == v && fabsf(v) < 1e30f) ? v : 12345.f;
    }
}
#endif
#ifndef N_LAUNCHES
#define N_LAUNCHES 1
#endif
extern "C" void kernel_launch(void* const* d_in, const int* in_sizes, int n_in, void* d_out, int out_size, void* d_ws, size_t ws_size, hipStream_t stream) {
    static int grid_blocks = 0;
    if (grid_blocks == 0) {
        int dev = 0, cus = 0, per_cu = 0;
        (void)hipGetDevice(&dev); (void)hipDeviceGetAttribute(&cus, hipDeviceAttributeMultiprocessorCount, dev);
        (void)hipFuncSetAttribute((const void*)mega_fwd, hipFuncAttributeMaxDynamicSharedMemorySize, LDS_BYTES);
        (void)hipOccupancyMaxActiveBlocksPerMultiprocessor(&per_cu, (const void*)mega_fwd, 512, LDS_BYTES);
        if (per_cu < 1) per_cu = 1;
        grid_blocks = cus * per_cu;
        if (grid_blocks > 256) grid_blocks = 256;
        if (ws_size < WS_END || n_in != 18) { fprintf(stderr, "kernel_launch: unexpected ws_size %zu or n_in %d\n", ws_size, n_in); grid_blocks = -1; }
    }
    if (grid_blocks < 0) return;
    Params P{};
    P.x = (const float*)d_in[0]; P.mem = (const float*)d_in[1]; P.rel_bias = (const float*)d_in[2]; P.attn_w_in = (const float*)d_in[3]; P.attn_lambda = (const float*)d_in[4];
    P.attn_subln = (const float*)d_in[5]; P.hgrn_w_in = (const float*)d_in[6]; P.hgrn_lb = (const float*)d_in[7]; P.hgrn_norm = (const float*)d_in[8]; P.conv_w_in = (const float*)d_in[9];
    P.conv_w = (const float*)d_in[10]; P.mem_w_kv = (const float*)d_in[11]; P.w_o = (const float*)d_in[12]; P.ln_gain = (const float*)d_in[13]; P.ln_bias = (const float*)d_in[14];
    P.ffn_w_up = (const float*)d_in[15]; P.ffn_conv = (const float*)d_in[16]; P.ffn_w_down = (const float*)d_in[17];
    P.out = (float*)d_out; P.ws = (unsigned char*)d_ws;
    if (N_LAUNCHES == 1) {
        int lo = 0, hi = NPH, var0 = 0;
        void* args[] = {&P, &lo, &hi, &var0};
        hipError_t e = hipLaunchCooperativeKernel((const void*)mega_fwd, dim3(grid_blocks), dim3(512), args, LDS_BYTES, stream);
        if (e != hipSuccess) fprintf(stderr, "cooperative launch failed: %s (grid %d)\n", hipGetErrorString(e), grid_blocks);
    } else {
#ifdef DBG_LAST
        for (int ph = 0; ph <= DBG_LAST; ++ph) hipLaunchKernelGGL(mega_fwd, dim3(grid_blocks), dim3(512), LDS_BYTES, stream, P, ph, ph + 1, 0);
        hipLaunchKernelGGL(dbg_dump_k, dim3(1024), dim3(256), 0, stream, P, DBG_BUF);
#else
#ifdef TIMING_DUMMY
        for (int r = 0; r < 4; ++r) hipLaunchKernelGGL(mega_fwd, dim3(grid_blocks), dim3(512), LDS_BYTES, stream, P, -1, 0, TIMING_DUMMY);
#endif
        for (int ph = 0; ph < NPH; ++ph) {
#ifdef DUP_PH
            if (ph == DUP_PH) for (int r = 0; r < DUP_N; ++r) hipLaunchKernelGGL(mega_fwd, dim3(grid_blocks), dim3(512), LDS_BYTES, stream, P, ph, ph + 1, DUP_VAR);
#endif
            hipLaunchKernelGGL(mega_fwd, dim3(grid_blocks), dim3(512), LDS_BYTES, stream, P, ph, ph + 1, 0);
#ifdef DUP_PH

#endif
        }
#endif
    }
}
```

```cpp
#include <hip/hip_runtime.h>
#include <hip/hip_cooperative_groups.h>
#include <cstdio>
namespace cg = cooperative_groups;

__device__ __forceinline__ int otid() { int t = threadIdx.x; asm volatile("" : "+v"(t)); return t; }
#ifndef PG8_WGM
#define PG8_WGM 8
#endif
#ifndef PG8_AUX
#define PG8_AUX 0
#endif
namespace pg8 {
#define PG8_LAS __attribute__((address_space(3)))
typedef unsigned short bf16_t;
typedef short bf16x8 __attribute__((ext_vector_type(8)));
typedef float f32x4 __attribute__((ext_vector_type(4)));
typedef unsigned u32x4 __attribute__((ext_vector_type(4)));
constexpr int BM = 256, BK = 64, HALF = 128, HTB = HALF * BK * 2  , STAGE_BYTES = 8 * HTB, NXCD = 8, WGM = PG8_WGM;

__host__ __device__ __forceinline__ int lds_byte(int r, int c) { const int st = (r >> 4) * 2 + (c >> 5), rr = r & 15, cc = c & 31, ob = rr * 64 + cc * 2; return st * 1024 + (ob ^ (((ob >> 9) & 1) << 5)); }
__host__ __device__ __forceinline__ void stage_rc(int b, int& R, int& C) { const int st = b / 1024, sb = b % 1024, swz = sb ^ (((sb >> 9) & 1) << 5); R = (st >> 1) * 16 + swz / 64; C = (st & 1) * 32 + (swz % 64) / 2; }
__host__ __device__ __forceinline__ int perm32(int rho) { const int n = rho >> 4, i = rho & 15; return 8 * (i >> 2) + 4 * n + (i & 3); }
struct Unit { int pm, pn; };
struct Gemm { const bf16_t* A; const bf16_t* Bt; int M, N, K; };
struct StaticOrder {
    int nM, nN, nwg, G, c;
    __host__ __device__ void init(int M, int N, int G_, int c_) { nM = M / BM; nN = N / BM; nwg = nM * nN; G = G_; c = c_; }
    __host__ __device__ bool next(int i, Unit& u) const {
        const long L = (long)i * G + c; if (L >= nwg) return false;
        int wgid = (int)L; { const int q = nwg / NXCD, r = nwg % NXCD, xcd = wgid % NXCD, off = wgid / NXCD; wgid = (xcd < r ? xcd * (q + 1) : r * (q + 1) + (xcd - r) * q) + off; }
        const int nig = WGM * nN, gid = wgid / nig, fm = gid * WGM, gsz = (nM - fm) < WGM ? (nM - fm) : WGM;
        u.pm = fm + ((wgid % nig) % gsz); u.pn = (wgid % nig) / gsz; return true;
    }
    __device__ __forceinline__ void a_ready(const Unit&) const {}
    __device__ __forceinline__ void done(const Unit&) const {}
};
typedef __bf16 pg8_bf2 __attribute__((ext_vector_type(2)));
typedef float pg8_f2 __attribute__((ext_vector_type(2)));
__device__ __forceinline__ unsigned cvt_pk_bf16(float lo, float hi) { pg8_f2 v; v.x = lo; v.y = hi; return __builtin_bit_cast(unsigned, __builtin_convertvector(v, pg8_bf2)); }
template <class Epi, class Sched, bool STAMP = false>
__device__ __forceinline__ void gemm_phase(PG8_LAS unsigned char* lds, const Gemm g, const Sched& S, const Epi& E, unsigned long long* stamps) {
    const int tid = otid(), wid = __builtin_amdgcn_readfirstlane(tid >> 6), lane = tid & 63, wr = wid >> 2, wc = wid & 3, fr = lane & 15, fq = lane >> 4;
    const int K = g.K, nt = K / BK;
    int ts_lo = 0, ts_hi = 0, nts = 0; const unsigned long long rt_entry = STAMP ? (unsigned long long)wall_clock64() : 0ull;
#define PG8_STAMP() do { if (STAMP && wid == 0 && nts < 64) { const unsigned long long _c = (unsigned long long)clock64(); \
        ts_lo = (lane == nts) ? (int)(unsigned)_c : ts_lo; ts_hi = (lane == nts) ? (int)(unsigned)(_c >> 32) : ts_hi; ++nts; } } while (0)
    PG8_STAMP();
    unsigned voffA[2], voffB[2];
#pragma unroll
    for (int i = 0; i < 2; ++i) { int R, C; stage_rc(tid * 16 + i * 8192, R, C); const int Rb = Epi::PERM ? ((R & ~31) + perm32(R & 31)) : R;
        voffA[i] = (unsigned)(R * K + C) * 2u; voffB[i] = (unsigned)(Rb * K + C) * 2u; }
    const size_t kstep = (size_t)(BK * 2);
    const size_t hstep = (size_t)HALF * K * 2;
    const size_t tstep = 2 * hstep;
    const unsigned ldsw = (unsigned)wid * 1024u;
    const int aoff = lds_byte(wr * 64 + fr, fq * 8), boff = lds_byte(wc * 32 + fr, fq * 8);
#define PG8_SA(b, h) (((b) * 2 + (h)) * HTB)
#define PG8_SB(b, h) ((4 + (b) * 2 + (h)) * HTB)
#define PG8_STAGE(bufoff, gbase, voff) do { _Pragma("unroll") for (int _i = 0; _i < 2; ++_i) \
        __builtin_amdgcn_global_load_lds((const unsigned*)((const char*)(gbase) + (voff)[_i]), (PG8_LAS unsigned*)(lds + (bufoff) + ldsw + _i * 8192), 16, 0, PG8_AUX); } while (0)
#define PG8_LDA(dst, b, h) do { _Pragma("unroll") for (int m = 0; m < 4; ++m) _Pragma("unroll") for (int k = 0; k < 2; ++k) dst[m][k] = *(const PG8_LAS bf16x8*)(lds + PG8_SA(b, h) + aoff + m * 2048 + k * 1024); } while (0)
#define PG8_LDB(dst, b, h) do { _Pragma("unroll") for (int n = 0; n < 2; ++n) _Pragma("unroll") for (int k = 0; k < 2; ++k) dst[n][k] = *(const PG8_LAS bf16x8*)(lds + PG8_SB(b, h) + boff + n * 2048 + k * 1024); } while (0)
#define PG8_MMA(ai, bj, At, Bt) do { __builtin_amdgcn_s_setprio(1); _Pragma("unroll") for (int m = 0; m < 4; ++m) _Pragma("unroll") for (int n = 0; n < 2; ++n) _Pragma("unroll") for (int k = 0; k < 2; ++k) \
        acc[ai][bj][m][n] = __builtin_amdgcn_mfma_f32_16x16x32_bf16(Bt[n][k], At[m][k], acc[ai][bj][m][n], 0, 0, 0); __builtin_amdgcn_s_setprio(0); } while (0)
#define PG8_WAIT_V(n) asm volatile("s_waitcnt vmcnt(" #n ")" ::: "memory")
#define PG8_WAIT_L(n) asm volatile("s_waitcnt lgkmcnt(" #n ")" ::: "memory")
#define PG8_BAR __builtin_amdgcn_s_barrier()
#define PG8_SCHED __builtin_amdgcn_sched_barrier(0)
    Unit cur, nxt; int ui = 0;
    if (!S.next(0, cur)) return;
    f32x4 acc[2][2][4][2];
#pragma unroll
    for (int a = 0; a < 2; ++a)
#pragma unroll
        for (int b = 0; b < 2; ++b)
#pragma unroll
            for (int m = 0; m < 4; ++m)
#pragma unroll
                for (int n = 0; n < 2; ++n) acc[a][b][m][n] = (f32x4){0.f, 0.f, 0.f, 0.f};
    bf16x8 At[4][2], B0[2][2], B1[2][2];
    const char* cA = (const char*)g.A + (size_t)cur.pm * tstep; const char* cB = (const char*)g.Bt + (size_t)cur.pn * tstep;
    S.a_ready(cur);
    PG8_STAGE(PG8_SB(0, 0), cB, voffB); PG8_STAGE(PG8_SA(0, 0), cA, voffA); PG8_STAGE(PG8_SB(0, 1), cB + hstep, voffB); PG8_STAGE(PG8_SA(0, 1), cA + hstep, voffA);
    if (wr == 1) PG8_BAR;
    PG8_WAIT_V(4); PG8_BAR;
    PG8_STAGE(PG8_SB(1, 0), cB + kstep, voffB); PG8_STAGE(PG8_SA(1, 0), cA + kstep, voffA); PG8_STAGE(PG8_SB(1, 1), cB + hstep + kstep, voffB);
    PG8_WAIT_V(6); PG8_BAR;
    PG8_STAMP();
    for (;;) {
        const bool has_next = S.next(ui + 1, nxt);
        const char* nA = has_next ? (const char*)g.A + (size_t)nxt.pm * tstep : cA; const char* nB = has_next ? (const char*)g.Bt + (size_t)nxt.pn * tstep : cB;
        for (int t = 0; t < nt; t += 2) {
            const bool last = (t == nt - 2);
            const char* a1 = cA + (size_t)(t + 1) * kstep;
            const char* a2 = last ? nA : cA + (size_t)(t + 2) * kstep; const char* b2 = last ? nB : cB + (size_t)(t + 2) * kstep;
            const char* a3 = a2 + kstep; const char* b3 = b2 + kstep;
            if (last && has_next) S.a_ready(nxt);
            PG8_LDB(B0, 0, 0); PG8_SCHED; PG8_LDA(At, 0, 0); PG8_STAGE(PG8_SA(1, 1), a1 + hstep, voffA);
            PG8_WAIT_L(8); PG8_BAR; PG8_WAIT_L(0); PG8_MMA(0, 0, At, B0); PG8_BAR; PG8_SCHED;
            PG8_LDB(B1, 0, 1); PG8_STAGE(PG8_SB(0, 0), b2, voffB);
            PG8_BAR; PG8_WAIT_L(0); PG8_MMA(0, 1, At, B1); PG8_BAR;
            PG8_LDA(At, 0, 1); PG8_STAGE(PG8_SA(0, 0), a2, voffA);
            PG8_BAR; PG8_WAIT_L(0); PG8_MMA(1, 0, At, B0); PG8_BAR; PG8_SCHED;
            PG8_STAGE(PG8_SB(0, 1), b2 + hstep, voffB);
            PG8_WAIT_V(6); PG8_BAR; PG8_MMA(1, 1, At, B1); PG8_BAR;
            PG8_LDB(B0, 1, 0); PG8_SCHED; PG8_LDA(At, 1, 0); PG8_STAGE(PG8_SA(0, 1), a2 + hstep, voffA);
            PG8_WAIT_L(8); PG8_BAR; PG8_WAIT_L(0); PG8_MMA(0, 0, At, B0); PG8_BAR; PG8_SCHED;
            PG8_LDB(B1, 1, 1); PG8_STAGE(PG8_SB(1, 0), b3, voffB);
            PG8_BAR; PG8_WAIT_L(0); PG8_MMA(0, 1, At, B1); PG8_BAR;
            PG8_LDA(At, 1, 1); PG8_STAGE(PG8_SA(1, 0), a3, voffA);
            PG8_BAR; PG8_WAIT_L(0); PG8_MMA(1, 0, At, B0); PG8_BAR; PG8_SCHED;
            PG8_STAGE(PG8_SB(1, 1), b3 + hstep, voffB);
            PG8_WAIT_V(6); PG8_BAR; PG8_MMA(1, 1, At, B1); PG8_BAR;
        }
        PG8_STAMP();
        if constexpr (!Epi::AFTER_DRAIN) { E(acc, cur, wr, wc, fr, fq); S.done(cur); }
        PG8_STAMP();
        if (!has_next) break;
#pragma unroll
        for (int a = 0; a < 2; ++a)
#pragma unroll
            for (int b = 0; b < 2; ++b)
#pragma unroll
                for (int m = 0; m < 4; ++m)
#pragma unroll
                    for (int n = 0; n < 2; ++n) acc[a][b][m][n] = (f32x4){0.f, 0.f, 0.f, 0.f};
        cur = nxt; cA = nA; cB = nB; ++ui;
    }
    PG8_WAIT_V(0);
    if (wr == 0) PG8_BAR;
    PG8_BAR;
    if constexpr (Epi::AFTER_DRAIN) { E.fused(acc, cur, wr, wc, fr, fq, lds, wid, lane); S.done(cur); }
    PG8_STAMP();
    if (STAMP && wid == 0) { stamps[lane] = lane < nts ? (((unsigned long long)(unsigned)ts_hi << 32) | (unsigned)ts_lo) : 0ull;
        if (lane == 62) stamps[62] = rt_entry; if (lane == 63) stamps[63] = (unsigned long long)wall_clock64(); }
#undef PG8_STAMP
#undef PG8_SA
#undef PG8_SB
#undef PG8_STAGE
#undef PG8_LDA
#undef PG8_LDB
#undef PG8_MMA
#undef PG8_WAIT_V
#undef PG8_WAIT_L
#undef PG8_BAR
#undef PG8_SCHED
}
}

using pg8::bf16_t; using pg8::bf16x8; using pg8::f32x4; using pg8::u32x4; using pg8::cvt_pk_bf16;
#define LAS PG8_LAS
typedef unsigned u32x2 __attribute__((ext_vector_type(2)));

constexpr int D = 1024, NTOK = 32768, SEQ = 8192, MIXW = 768, DFF = 2816;
constexpr float ALPHA = 1.6817928305074290f, LN_EPS = 1e-5f, LOG2E = 1.4426950408889634f;
constexpr size_t MiB = 1048576;
constexpr size_t WS_WIN = 0, WS_WO = 8 * MiB, WS_WUP = 10 * MiB, WS_WDN = 21 * MiB, WS_WKV = 27 * MiB, WS_MEMB = 31 * MiB, WS_KVM = 33 * MiB,
                 WS_ELAST = 37 * MiB, WS_XB = 40 * MiB, WS_BIG = 104 * MiB, WS_OB = 424 * MiB, WS_LNST = 472 * MiB, WS_END = 473 * MiB;
constexpr size_t BIG_MIX = 256 * MiB, BIG_U = 176 * MiB;
constexpr int LDS_BYTES = 4 * (64 * 272 + 128 * 144) + 2048;

struct Params {
    const float *x, *mem, *rel_bias, *attn_w_in, *attn_lambda, *attn_subln, *hgrn_w_in, *hgrn_lb, *hgrn_norm, *conv_w_in, *conv_w, *mem_w_kv, *w_o,
                *ln_gain, *ln_bias, *ffn_w_up, *ffn_conv, *ffn_w_down;
    float* out; unsigned char* ws;
};

__device__ __forceinline__ float bf2f(unsigned short h) { return __uint_as_float(((unsigned)h) << 16); }
__device__ __forceinline__ float bflo(unsigned w) { return __uint_as_float(w << 16); }
__device__ __forceinline__ float bfhi(unsigned w) { return __uint_as_float(w & 0xffff0000u); }
__device__ __forceinline__ float fast_exp2(float x) { return __builtin_amdgcn_exp2f(x); }
__device__ __forceinline__ float sigmoidf_(float x) { return 1.0f / (1.0f + __expf(-x)); }
__device__ __forceinline__ float siluf_(float x) { return x / (1.0f + __expf(-x)); }
__device__ __forceinline__ float fast_sigmoid(float x) { return __builtin_amdgcn_rcpf(1.0f + __builtin_amdgcn_exp2f(-1.4426950408889634f * x)); }
__device__ __forceinline__ float fast_silu(float x) { return x * fast_sigmoid(x); }

__device__ __forceinline__ void cvt_tile(const float* src, int ldsrc, int k0, int c0, bf16_t* dst, int lddst, int r0, float scale, LAS float* scr) {
    const int tid = otid();
    { const int n = tid & 63, kk = tid >> 6;
#pragma unroll
      for (int i = 0; i < 8; ++i) scr[(kk + 8 * i) * 65 + n] = src[(size_t)(k0 + kk + 8 * i) * ldsrc + c0 + n] * scale; }
    __syncthreads();
    { const int kp = tid & 31, nn = tid >> 5;
#pragma unroll
      for (int i = 0; i < 4; ++i) { const int n = nn + 16 * i;
          *(unsigned*)(dst + (size_t)(r0 + n) * lddst + k0 + 2 * kp) = cvt_pk_bf16(scr[(2 * kp) * 65 + n], scr[(2 * kp + 1) * 65 + n]); } }
    __syncthreads();
}
__device__ __forceinline__ void convert_layer(const Params& P, int layer, LAS unsigned char* lds) {
    LAS float* scr = (LAS float*)lds;
#ifdef DBG_KIND1
    const int kind = 1, jj = 0;
#else
    const int kind = layer % 3, jj = layer / 3;
#endif
    const int NIN = kind == 1 ? 4096 : 2560;
    const float* win = kind == 0 ? P.attn_w_in + (size_t)jj * D * 2560 : (kind == 1 ? P.hgrn_w_in + (size_t)jj * D * 4096 : P.conv_w_in + (size_t)jj * D * 2560);
#ifdef DBG_WALT
    bf16_t* Wt_in = (bf16_t*)(P.ws + (layer == 1 ? WS_OB : WS_WIN));
#else
    bf16_t* Wt_in = (bf16_t*)(P.ws + WS_WIN);
#endif
    bf16_t* Wt_o = (bf16_t*)(P.ws + WS_WO); bf16_t* Wt_up = (bf16_t*)(P.ws + WS_WUP); bf16_t* Wt_dn = (bf16_t*)(P.ws + WS_WDN);
    const int T_IN = (NIN / 64) * 16, T_O = 256, T_UP = 88 * 16, T_DN = 16 * 44, T_ALL = T_IN + T_O + T_UP + T_DN;
    for (int it = blockIdx.x; it < T_ALL; it += gridDim.x) {
        int r = it;
        if (r < T_IN) { const int nt = r >> 4, kt = r & 15; const int c0 = nt * 64;
            const bool qcol = (kind == 0 && c0 < MIXW) || (c0 >= NIN - 256);
            cvt_tile(win, NIN, kt * 64, c0, Wt_in, D, c0, qcol ? 0.125f * LOG2E : 1.0f, scr); continue; }
        r -= T_IN;
        if (r < T_O) { const int nt = r >> 4, kt = r & 15; cvt_tile(P.w_o + (size_t)layer * D * D, D, kt * 64, nt * 64, Wt_o, D, nt * 64, 1.0f, scr); continue; }
        r -= T_O;
        if (r < T_UP) { const int nt = r >> 4, kt = r & 15; const int j = nt >> 2, q = nt & 3; const int c0 = q < 2 ? j * 128 + q * 64 : DFF + j * 128 + (q - 2) * 64;
            cvt_tile(P.ffn_w_up + (size_t)layer * D * 2 * DFF, 2 * DFF, kt * 64, c0, Wt_up, D, nt * 64, 1.0f, scr); continue; }
        r -= T_UP;
        { const int nt = r / 44, kt = r % 44; cvt_tile(P.ffn_w_down + (size_t)layer * DFF * D, D, kt * 64, nt * 64, Wt_dn, DFF, nt * 64, 1.0f, scr); }
    }
}
__device__ __forceinline__ void convert_prologue(const Params& P, LAS unsigned char* lds) {
    LAS float* scr = (LAS float*)lds;
    bf16_t* Wt_kv = (bf16_t*)(P.ws + WS_WKV);
    for (int it = blockIdx.x; it < 512; it += gridDim.x) { const int l = it >> 7, r = it & 127, nt = r >> 4, kt = r & 15;
        cvt_tile(P.mem_w_kv + (size_t)l * D * 512, 512, kt * 64, nt * 64, Wt_kv, D, l * 512 + nt * 64, 1.0f, scr); }
    const size_t gt = (size_t)blockIdx.x * 512 + otid(), gs = (size_t)gridDim.x * 512;
    { const f32x4* s = (const f32x4*)P.x; u32x2* d = (u32x2*)(P.ws + WS_XB);
      for (size_t i = gt; i < (size_t)NTOK * D / 4; i += gs) { const f32x4 v = s[i]; u32x2 o; o.x = cvt_pk_bf16(v.x, v.y); o.y = cvt_pk_bf16(v.z, v.w); d[i] = o; } }
    { const f32x4* s = (const f32x4*)P.mem; u32x2* d = (u32x2*)(P.ws + WS_MEMB);
      for (size_t i = gt; i < (size_t)1024 * D / 4; i += gs) { const f32x4 v = s[i]; u32x2 o; o.x = cvt_pk_bf16(v.x, v.y); o.y = cvt_pk_bf16(v.z, v.w); d[i] = o; } }
}

struct EpiBf16P {
    static constexpr bool PERM = true, AFTER_DRAIN = false;
    bf16_t* O; int ldc;
    __device__ __forceinline__ void operator()(const f32x4 (&acc)[2][2][4][2], const pg8::Unit& u, int wr, int wc, int fr, int fq) const {
        const int row0 = u.pm * 256 + wr * 64 + fr, col0 = u.pn * 256 + wc * 32 + 8 * fq;
#pragma unroll
        for (int ai = 0; ai < 2; ++ai)
#pragma unroll
            for (int m = 0; m < 4; ++m) { bf16_t* rowp = O + (size_t)(row0 + ai * 128 + m * 16) * ldc + col0;
#pragma unroll
                for (int bj = 0; bj < 2; ++bj) { const f32x4 v0 = acc[ai][bj][m][0], v1 = acc[ai][bj][m][1];
                    u32x4 w; w.x = cvt_pk_bf16(v0[0], v0[1]); w.y = cvt_pk_bf16(v0[2], v0[3]); w.z = cvt_pk_bf16(v1[0], v1[1]); w.w = cvt_pk_bf16(v1[2], v1[3]);
                    *(u32x4*)(rowp + bj * 128) = w; } }
    }
};
struct EpiResid {
    static constexpr bool PERM = false, AFTER_DRAIN = false;
    float* io; const float* xin; const float* stats; const float* lg; const float* lb;
    __device__ __forceinline__ void operator()(const f32x4 (&acc)[2][2][4][2], const pg8::Unit& u, int wr, int wc, int fr, int fq) const {
        const int row0 = u.pm * 256 + wr * 64 + fr, col0 = u.pn * 256 + wc * 32 + 4 * fq;
#pragma unroll
        for (int bj = 0; bj < 2; ++bj)
#pragma unroll
            for (int n = 0; n < 2; ++n) {
                const int cc = col0 + bj * 128 + n * 16;
                f32x4 gv = (f32x4){1.f, 1.f, 1.f, 1.f}, bv = (f32x4){0.f, 0.f, 0.f, 0.f};
                if (stats) { gv = *(const f32x4*)(lg + cc); bv = *(const f32x4*)(lb + cc); }
#pragma unroll
                for (int ai = 0; ai < 2; ++ai)
#pragma unroll
                    for (int m = 0; m < 4; ++m) { const int row = row0 + ai * 128 + m * 16; const size_t ro = (size_t)row * D + cc;
                        f32x4 xv = *(const f32x4*)(xin + ro);
                        if (stats) { const float mean = stats[2 * row], rstd = stats[2 * row + 1]; xv = (xv - mean) * rstd * gv + bv; }
                        *(f32x4*)(io + ro) = xv * ALPHA + acc[ai][bj][m][n]; }
            }
    }
};

__device__ __forceinline__ float dpp_ror1(float x) { return __builtin_bit_cast(float, __builtin_amdgcn_update_dpp(0, __builtin_bit_cast(int, x), 0x121, 0xf, 0xf, false)); }
__device__ __forceinline__ float dpp_ror15(float x) { return __builtin_bit_cast(float, __builtin_amdgcn_update_dpp(0, __builtin_bit_cast(int, x), 0x12f, 0xf, 0xf, false)); }
struct EpiGate {
    static constexpr bool PERM = false, AFTER_DRAIN = false;
    bf16_t* g; float* edge; const float* cw; LAS unsigned char* xl;
    __device__ __forceinline__ void operator()(const f32x4 (&acc)[2][2][4][2], const pg8::Unit& u, int wr, int wc, int fr, int fq) const {
        LAS f32x4* X = (LAS f32x4*)xl;
        const int cq = wc * 8 + fq;
        if (fr == 0) {
#pragma unroll
            for (int ai = 0; ai < 2; ++ai)
#pragma unroll
                for (int bj = 0; bj < 2; ++bj)
#pragma unroll
                    for (int n = 0; n < 2; ++n) X[(((ai * 2 + wr) * 2 + 0) * 2 + bj) * 32 + cq + 4 * n] = acc[ai][bj][0][n];
        }
        if (fr == 15) {
#pragma unroll
            for (int ai = 0; ai < 2; ++ai)
#pragma unroll
                for (int bj = 0; bj < 2; ++bj)
#pragma unroll
                    for (int n = 0; n < 2; ++n) X[(((ai * 2 + wr) * 2 + 1) * 2 + bj) * 32 + cq + 4 * n] = acc[ai][bj][3][n];
        }
        asm volatile("s_waitcnt lgkmcnt(0)" ::: "memory");
        __builtin_amdgcn_s_barrier(); __builtin_amdgcn_s_barrier();
        asm volatile("" ::: "memory");
        const int colbase = u.pn * 128 + wc * 32 + 4 * fq;
        const size_t row0 = (size_t)u.pm * 256 + wr * 64 + fr;
#pragma unroll
        for (int ai = 0; ai < 2; ++ai) {
            const int seg = ai * 2 + wr;
#pragma unroll
            for (int n = 0; n < 2; ++n) {
                f32x4 h[2][4];
#pragma unroll
                for (int bj = 0; bj < 2; ++bj) {
                    f32x4 wgt[3];
#pragma unroll
                    for (int t = 0; t < 3; ++t) wgt[t] = *(const f32x4*)(cw + (size_t)t * 2 * DFF + bj * DFF + colbase + 16 * n);
                    const f32x4 hp = seg > 0 ? X[(((seg - 1) * 2 + 1) * 2 + bj) * 32 + cq + 4 * n] : (f32x4){0.f, 0.f, 0.f, 0.f};
                    const f32x4 hn = seg < 3 ? X[(((seg + 1) * 2 + 0) * 2 + bj) * 32 + cq + 4 * n] : (f32x4){0.f, 0.f, 0.f, 0.f};
#pragma unroll
                    for (int i = 0; i < 4; ++i) {
                        float R[4], L[4];
#pragma unroll
                        for (int m = 0; m < 4; ++m) { R[m] = dpp_ror1(acc[ai][bj][m][n][i]); L[m] = dpp_ror15(acc[ai][bj][m][n][i]); }
#pragma unroll
                        for (int m = 0; m < 4; ++m) {
                            const float pv_ = fr == 0 ? (m == 0 ? hp[i] : R[m == 0 ? 0 : m - 1]) : R[m];
                            const float nx_ = fr == 15 ? (m == 3 ? hn[i] : L[m == 3 ? 3 : m + 1]) : L[m];
                            h[bj][m][i] = wgt[0][i] * pv_ + wgt[1][i] * acc[ai][bj][m][n][i] + wgt[2][i] * nx_;
                        }
                    }
                    __builtin_amdgcn_sched_barrier(0);
                }
#pragma unroll
                for (int m = 0; m < 4; ++m) {
                    const f32x4 a = h[0][m], v = h[1][m];
                    u32x2 w; w.x = cvt_pk_bf16(fast_silu(a[0]) * v[0], fast_silu(a[1]) * v[1]); w.y = cvt_pk_bf16(fast_silu(a[2]) * v[2], fast_silu(a[3]) * v[3]);
                    *(u32x2*)(g + (row0 + ai * 128 + m * 16) * DFF + colbase + 16 * n) = w;
                }
                __builtin_amdgcn_sched_barrier(0);
            }
        }
        const int ecol = u.pn * 256 + wc * 32 + 4 * fq;
        if (wr == 0 && fr < 2) {
#pragma unroll
            for (int bj = 0; bj < 2; ++bj)
#pragma unroll
                for (int n = 0; n < 2; ++n) *(f32x4*)(edge + ((size_t)u.pm * 4 + fr) * (2 * DFF) + ecol + bj * 128 + 16 * n) = acc[0][bj][0][n];
        }
        if (wr == 1 && fr >= 14) {
#pragma unroll
            for (int bj = 0; bj < 2; ++bj)
#pragma unroll
                for (int n = 0; n < 2; ++n) *(f32x4*)(edge + ((size_t)u.pm * 4 + (fr - 12)) * (2 * DFF) + ecol + bj * 128 + 16 * n) = acc[1][bj][3][n];
        }
    }
};
__device__ __forceinline__ void gate_fixup(const float* edge, bf16_t* g, const float* cw) {
    const int total = 128 * 2 * DFF;
    for (int it = blockIdx.x * 512 + otid(); it < total; it += gridDim.x * 512) {
        const int c = it % DFF, rr = (it / DFF) & 1, pm = it / (2 * DFF);
        const int pn = c >> 7, cc = c & 127, ea = pn * 256 + cc, ev = ea + 128;
        const float* E = edge + (size_t)pm * 4 * (2 * DFF);
        float pa, pv_, ca, cv, na, nv;
        if (rr == 0) {
            ca = E[0 * 2 * DFF + ea]; cv = E[0 * 2 * DFF + ev]; na = E[1 * 2 * DFF + ea]; nv = E[1 * 2 * DFF + ev];
            if ((pm & 31) == 0) { pa = 0.f; pv_ = 0.f; } else { pa = (E - 4 * (2 * DFF))[3 * 2 * DFF + ea]; pv_ = (E - 4 * (2 * DFF))[3 * 2 * DFF + ev]; }
        } else {
            pa = E[2 * 2 * DFF + ea]; pv_ = E[2 * 2 * DFF + ev]; ca = E[3 * 2 * DFF + ea]; cv = E[3 * 2 * DFF + ev];
            if ((pm & 31) == 31) { na = 0.f; nv = 0.f; } else { na = (E + 4 * (2 * DFF))[0 * 2 * DFF + ea]; nv = (E + 4 * (2 * DFF))[0 * 2 * DFF + ev]; }
        }
        const float ha = cw[c] * pa + cw[2 * DFF + c] * ca + cw[4 * DFF + c] * na;
        const float hv = cw[DFF + c] * pv_ + cw[3 * DFF + c] * cv + cw[5 * DFF + c] * nv;
        const float o = fast_silu(ha) * hv;
        g[((size_t)pm * 256 + rr * 255) * DFF + c] = (bf16_t)(cvt_pk_bf16(o, 0.f) & 0xffffu);
    }
}
template <class Epi>
__device__ __forceinline__ void run_gemm(LAS unsigned char* lds, const bf16_t* A, const bf16_t* Bt, int M, int N, int K, const Epi& E) {
    pg8::StaticOrder S; S.init(M, N, (int)gridDim.x, (int)blockIdx.x);
    pg8::Gemm g; g.A = A; g.Bt = Bt; g.M = M; g.N = N; g.K = K;
    pg8::gemm_phase<Epi, pg8::StaticOrder, false>(lds, g, S, E, nullptr);
    __syncthreads();
}

__device__ __forceinline__ float wave_sum(float v) {
#pragma unroll
    for (int o = 32; o >= 1; o >>= 1) v += __shfl_xor(v, o);
    return v;
}
__device__ __forceinline__ void ln_phase(float* io, bf16_t* xb, const float* gain, const float* bias, float* stats, bool wf32) {
    const int lane = otid() & 63, wid = otid() >> 6;
    f32x4 gv[4], bv[4];
#pragma unroll
    for (int j = 0; j < 4; ++j) { gv[j] = ((const f32x4*)gain)[lane + 64 * j]; bv[j] = ((const f32x4*)bias)[lane + 64 * j]; }
    for (int rg = (blockIdx.x * 8 + wid) * 4; rg < NTOK / 4; rg += gridDim.x * 8 * 4)
    for (int r0 = 0; r0 < 16; r0 += 4) {
        f32x4 v[4][4];
#pragma unroll
        for (int r = 0; r < 4; ++r) { const int row = rg * 4 + r0 + r; const f32x4* xr = (const f32x4*)(io + (size_t)row * D) + lane;
#pragma unroll
            for (int j = 0; j < 4; ++j) v[r][j] = xr[64 * j]; }
#pragma unroll
        for (int r = 0; r < 4; ++r) {
            const int row = rg * 4 + r0 + r;
            float s = 0.f;
#pragma unroll
            for (int j = 0; j < 4; ++j) s += (v[r][j].x + v[r][j].y) + (v[r][j].z + v[r][j].w);
            const float mean = wave_sum(s) * (1.f / D); float s2 = 0.f;
#pragma unroll
            for (int j = 0; j < 4; ++j) { v[r][j] = v[r][j] - mean; s2 += (v[r][j].x * v[r][j].x + v[r][j].y * v[r][j].y) + (v[r][j].z * v[r][j].z + v[r][j].w * v[r][j].w); }
            const float rstd = 1.0f / sqrtf(wave_sum(s2) * (1.f / D) + LN_EPS);
            f32x4* xr = (f32x4*)(io + (size_t)row * D) + lane; u32x2* o8 = (u32x2*)(xb + (size_t)row * D) + lane;
            if (lane == 0) { stats[2 * row] = mean; stats[2 * row + 1] = rstd; }
#pragma unroll
            for (int j = 0; j < 4; ++j) { const f32x4 y = v[r][j] * rstd * gv[j] + bv[j]; if (wf32) xr[64 * j] = y;
                u32x2 o; o.x = cvt_pk_bf16(y.x, y.y); o.y = cvt_pk_bf16(y.z, y.w); o8[64 * j] = o; }
        }
    }
}

__device__ __forceinline__ void unpack8(const u32x4 w, float (&f)[8]) {
    f[0] = bflo(w.x); f[1] = bfhi(w.x); f[2] = bflo(w.y); f[3] = bfhi(w.y); f[4] = bflo(w.z); f[5] = bfhi(w.z); f[6] = bflo(w.w); f[7] = bfhi(w.w);
}
__device__ __forceinline__ void gate_phase(const bf16_t* u, int ldu, int tile0, int ntile, bf16_t* g, const float* cw  ) {
    const int tid = otid();
    const int combo = tid & 127, sub = tid >> 7;
    const int jj = combo >> 4, cg = combo & 15;
    if (jj >= ntile) return;
    const int ca = (tile0 + jj) * 128 + cg * 8, cv = DFF + ca;
    float wa[3][8], wv[3][8];
#pragma unroll
    for (int t = 0; t < 3; ++t)
#pragma unroll
        for (int i = 0; i < 8; ++i) { wa[t][i] = cw[(size_t)t * 2 * DFF + ca + i]; wv[t][i] = cw[(size_t)t * 2 * DFF + cv + i]; }
    const u32x4 zero4 = (u32x4){0u, 0u, 0u, 0u};
    for (int strip = blockIdx.x; strip < NTOK / 32; strip += gridDim.x) {
        const int t0 = strip * 32 + sub * 8;
        const bf16_t* ua = u + (size_t)t0 * ldu + jj * 256 + cg * 8;
        u32x4 ra[10], rv[10];
#pragma unroll
        for (int r = 0; r < 10; ++r) {
            const int tt = t0 - 1 + r;
            const bool valid = !((r == 0 && (t0 & (SEQ - 1)) == 0) || (r == 9 && ((t0 + 8) & (SEQ - 1)) == 0));
            if (valid) { ra[r] = *(const u32x4*)(ua + (ptrdiff_t)(r - 1) * ldu); rv[r] = *(const u32x4*)(ua + (ptrdiff_t)(r - 1) * ldu + 128); }
            else { ra[r] = zero4; rv[r] = zero4; }
            (void)tt;
        }
#pragma unroll
        for (int t = 0; t < 8; ++t) {
            float fpa[8], fca[8], fna[8], fpv[8], fcv[8], fnv[8], o[8];
            unpack8(ra[t], fpa); unpack8(ra[t + 1], fca); unpack8(ra[t + 2], fna); unpack8(rv[t], fpv); unpack8(rv[t + 1], fcv); unpack8(rv[t + 2], fnv);
#pragma unroll
            for (int i = 0; i < 8; ++i) { const float ha = wa[0][i] * fpa[i] + wa[1][i] * fca[i] + wa[2][i] * fna[i];
                const float hv = wv[0][i] * fpv[i] + wv[1][i] * fcv[i] + wv[2][i] * fnv[i]; o[i] = siluf_(ha) * hv; }
            u32x4 w; w.x = cvt_pk_bf16(o[0], o[1]); w.y = cvt_pk_bf16(o[2], o[3]); w.z = cvt_pk_bf16(o[4], o[5]); w.w = cvt_pk_bf16(o[6], o[7]);
            *(u32x4*)(g + (size_t)(t0 + t) * DFF + ca) = w;
        }
    }
}

__device__ __forceinline__ void shortconv_phase(const bf16_t* p, int ldp, bf16_t* mix, const float* cw  ) {
    const int tid = otid();
    if (tid >= 384) return;
    const int cg = tid % 96, sub = tid / 96, c = cg * 8;
    float w[3][8];
#pragma unroll
    for (int t = 0; t < 3; ++t)
#pragma unroll
        for (int i = 0; i < 8; ++i) w[t][i] = cw[t * MIXW + c + i];
    for (int strip = blockIdx.x; strip < NTOK / 64; strip += gridDim.x) {
        const int t0 = strip * 64 + sub * 16;
        const bf16_t* pr = p + (size_t)t0 * ldp + c;
        float pp[8], pc[8], pn[8], a[8], b[8];
        if ((t0 & (SEQ - 1)) == 0) {
#pragma unroll
            for (int i = 0; i < 8; ++i) pp[i] = 0.f;
        } else { unpack8(*(const u32x4*)(pr - ldp + MIXW), a); unpack8(*(const u32x4*)(pr - ldp + 2 * MIXW), b);
#pragma unroll
            for (int i = 0; i < 8; ++i) pp[i] = a[i] * b[i]; }
        unpack8(*(const u32x4*)(pr + MIXW), a); unpack8(*(const u32x4*)(pr + 2 * MIXW), b);
#pragma unroll
        for (int i = 0; i < 8; ++i) pc[i] = a[i] * b[i];
#pragma unroll 2
        for (int t = 0; t < 16; ++t) {
            const int tt = t0 + t; const bf16_t* r = pr + (size_t)t * ldp;
            if ((tt & (SEQ - 1)) == SEQ - 1) {
#pragma unroll
                for (int i = 0; i < 8; ++i) pn[i] = 0.f;
            } else { unpack8(*(const u32x4*)(r + ldp + MIXW), a); unpack8(*(const u32x4*)(r + ldp + 2 * MIXW), b);
#pragma unroll
                for (int i = 0; i < 8; ++i) pn[i] = a[i] * b[i]; }
            float gb[8], o[8]; unpack8(*(const u32x4*)r, gb);
#pragma unroll
            for (int i = 0; i < 8; ++i) o[i] = gb[i] * (w[0][i] * pp[i] + w[1][i] * pc[i] + w[2][i] * pn[i]);
            u32x4 ow; ow.x = cvt_pk_bf16(o[0], o[1]); ow.y = cvt_pk_bf16(o[2], o[3]); ow.z = cvt_pk_bf16(o[4], o[5]); ow.w = cvt_pk_bf16(o[6], o[7]);
            *(u32x4*)(mix + (size_t)tt * D + c) = ow;
#pragma unroll
            for (int i = 0; i < 8; ++i) { pp[i] = pc[i]; pc[i] = pn[i]; }
        }
    }
}

__device__ __forceinline__ bf16x8 mk8(u32x2 lo, u32x2 hi) { u32x4 t; t.x = lo.x; t.y = lo.y; t.z = hi.x; t.w = hi.y; return __builtin_bit_cast(bf16x8, t); }
__device__ __forceinline__ f32x4 mfma16(bf16x8 a, bf16x8 b, f32x4 c) { return __builtin_amdgcn_mfma_f32_16x16x32_bf16(a, b, c, 0, 0, 0); }

__device__ __forceinline__ int t5_bucket(int rel) {
    const int n = rel < 0 ? -rel : rel; int b;
    if (n < 8) b = n; else { int lg = 2 + (31 - __clz(n * n)); b = lg > 15 ? 15 : lg; }
    return b + (rel > 0 ? 16 : 0);
}
#ifdef EXPV
__device__ int g_variant_dummy;
#endif
#ifdef ALL_LATE
#define FL_SB
#else
#define FL_SB __builtin_amdgcn_sched_barrier(0)
#endif
template <int MODE>
__device__ __forceinline__ void flash_item(int variant, LAS unsigned char* lds, const bf16_t* Qp, int ldq, const bf16_t* Kp, int ldk, const bf16_t* Vp, int ldv,
                                           int nkeys, int q0, const LAS float* btab, bf16_t* Op, const float* lamp, float lam_init, const float* subln, float outscale) {
    constexpr int EB = MODE ? 8 : 4, KROWB = MODE ? 256 : 128, KPITCH = KROWB + 16, VPITCH = 144, KBYTES = 64 * KPITCH, BUFB = KBYTES + EB * 16 * VPITCH;
    constexpr int KCH = KROWB / 16, NKL = 64 * KCH / 512;
    const int tid = otid(), lane = tid & 63, wid = __builtin_amdgcn_readfirstlane(tid >> 6), l15 = lane & 15, quad = lane >> 4;
    const int sub = MODE ? (wid >> 2) : 0, qrow0 = MODE ? (wid & 3) * 32 : wid * 32;
    bf16x8 Qf[2][2];
#pragma unroll
    for (int qt = 0; qt < 2; ++qt)
#pragma unroll
        for (int ks = 0; ks < 2; ++ks) Qf[qt][ks] = *(const bf16x8*)(Qp + (size_t)(qrow0 + qt * 16 + l15) * ldq + sub * 64 + ks * 32 + quad * 8);
    f32x4 O[2][EB];
#pragma unroll
    for (int qt = 0; qt < 2; ++qt)
#pragma unroll
        for (int eb = 0; eb < EB; ++eb) O[qt][eb] = (f32x4){0.f, 0.f, 0.f, 0.f};
    float lrun[2] = {0.f, 0.f}, mref[2];
    u32x4 kreg[NKL], vreg[2];
    const int veg = (EB == 8) ? ((wid & 3) * 4 + (lane & 3)) : ((wid & 1) * 4 + (lane & 3));
    const int vpair = (EB == 8) ? ((wid >> 2) * 16 + (lane >> 2)) : ((wid >> 1) * 16 + (lane >> 2));
    const bool vact = (EB == 8) || (wid < 4);
    auto gload = [&](int k0) {
#pragma unroll
        for (int i = 0; i < NKL; ++i) { const int c = tid + i * 512, chunk = c % KCH, key = c / KCH;
            kreg[i] = *(const u32x4*)(Kp + (size_t)(k0 + key) * ldk + chunk * 8); }
        if (vact) { vreg[0] = *(const u32x4*)(Vp + (size_t)(k0 + 2 * vpair) * ldv + veg * 8); vreg[1] = *(const u32x4*)(Vp + (size_t)(k0 + 2 * vpair + 1) * ldv + veg * 8); }
    };
    auto lstore = [&](int buf) {
        LAS unsigned char* kb = lds + buf * BUFB; LAS unsigned char* vb = kb + KBYTES;
#pragma unroll
        for (int i = 0; i < NKL; ++i) { const int c = tid + i * 512, chunk = c % KCH, key = c / KCH;
            *(LAS u32x4*)(kb + key * KPITCH + chunk * 16) = kreg[i]; }
        if (vact) {
            const unsigned a[4] = {vreg[0].x, vreg[0].y, vreg[0].z, vreg[0].w}, b[4] = {vreg[1].x, vreg[1].y, vreg[1].z, vreg[1].w};
            const int pl = vpair & 15, vdp = (vpair & 16) + 4 * ((pl & 7) >> 1) + 2 * (pl >> 3) + (pl & 1);
#pragma unroll
            for (int i = 0; i < 4; ++i) {
                *(LAS unsigned*)(vb + (veg * 8 + 2 * i) * VPITCH + vdp * 4) = (a[i] & 0xffffu) | (b[i] << 16);
                *(LAS unsigned*)(vb + (veg * 8 + 2 * i + 1) * VPITCH + vdp * 4) = (a[i] >> 16) | (b[i] & 0xffff0000u);
            }
        }
    };
    const int nt = nkeys / 64;
    gload(0); lstore(0); gload(64); lstore(1); __syncthreads();
    const int qlo = q0 + qrow0;
    {
        float mx0 = -INFINITY, mx1 = -INFINITY;
#pragma unroll
        for (int kb = 0; kb < 4; ++kb) {
            f32x4 S0 = (f32x4){0.f, 0.f, 0.f, 0.f}, S1 = (f32x4){0.f, 0.f, 0.f, 0.f};
#pragma unroll
            for (int ks = 0; ks < 2; ++ks) {
                const bf16x8 a = *(const LAS bf16x8*)(lds + (kb * 16 + l15) * KPITCH + sub * 128 + ks * 64 + quad * 16);
                S0 = mfma16(a, Qf[0][ks], S0); S1 = mfma16(a, Qf[1][ks], S1);
            }
            mx0 = fmaxf(mx0, fmaxf(fmaxf(S0[0], S0[1]), fmaxf(S0[2], S0[3]))); mx1 = fmaxf(mx1, fmaxf(fmaxf(S1[0], S1[1]), fmaxf(S1[2], S1[3])));
        }
        mx0 = fmaxf(mx0, __shfl_xor(mx0, 16)); mx0 = fmaxf(mx0, __shfl_xor(mx0, 32)); mx1 = fmaxf(mx1, __shfl_xor(mx1, 16)); mx1 = fmaxf(mx1, __shfl_xor(mx1, 32));
        mref[0] = mx0; mref[1] = mx1;
    }
    bf16x8 Pf[2][2];
    auto pv = [&](const LAS unsigned char* vbuf) {
#pragma unroll
        for (int g = 0; g < 2; ++g) {
            bf16x8 vf[EB];
#pragma unroll
            for (int eb = 0; eb < EB; ++eb) vf[eb] = *(const LAS bf16x8*)(vbuf + (eb * 16 + l15) * VPITCH + (32 * g + 8 * quad) * 2);
#pragma unroll
            for (int eb = 0; eb < EB; ++eb) { O[0][eb] = mfma16(vf[eb], Pf[0][g], O[0][eb]); O[1][eb] = mfma16(vf[eb], Pf[1][g], O[1][eb]); }
        }
    };
    auto sphase = [&](const LAS unsigned char* kbuf, int k0) {
        bool bnear = false; float bconst = 0.f;
        if (MODE) { if (k0 - (qlo + 31) >= 91) bconst = btab[511]; else if (qlo - (k0 + 63) >= 91) bconst = btab[0]; else bnear = true; }
        const float sh0 = bconst - mref[0], sh1 = bconst - mref[1];
        bf16x8 kf[4][2];
#pragma unroll
        for (int kb = 0; kb < 4; ++kb)
#pragma unroll
            for (int ks = 0; ks < 2; ++ks) kf[kb][ks] = *(const LAS bf16x8*)(kbuf + (kb * 16 + l15) * KPITCH + sub * 128 + ks * 64 + quad * 16);
        f32x4 S[2][4];
#pragma unroll
        for (int kb = 0; kb < 4; ++kb) { S[0][kb] = (f32x4){sh0, sh0, sh0, sh0}; S[1][kb] = (f32x4){sh1, sh1, sh1, sh1}; }
        if (MODE && bnear) {
#pragma unroll
            for (int kb = 0; kb < 4; ++kb) { const LAS float* bq = btab + (k0 + kb * 16 + quad * 4 - (qlo + l15) + 256);
#pragma unroll
                for (int j = 0; j < 4; ++j) { S[0][kb][j] += bq[j]; S[1][kb][j] += bq[j - 16]; } }
        }
#pragma unroll
        for (int kb = 0; kb < 4; ++kb)
#pragma unroll
            for (int ks = 0; ks < 2; ++ks) { S[0][kb] = mfma16(kf[kb][ks], Qf[0][ks], S[0][kb]); S[1][kb] = mfma16(kf[kb][ks], Qf[1][ks], S[1][kb]); }
#pragma unroll
        for (int qt = 0; qt < 2; ++qt) {
            float ls = 0.f;
#pragma unroll
            for (int kb = 0; kb < 4; ++kb) {
                S[qt][kb][0] = fast_exp2(S[qt][kb][0]); S[qt][kb][1] = fast_exp2(S[qt][kb][1]); S[qt][kb][2] = fast_exp2(S[qt][kb][2]); S[qt][kb][3] = fast_exp2(S[qt][kb][3]);
                ls += (S[qt][kb][0] + S[qt][kb][1]) + (S[qt][kb][2] + S[qt][kb][3]);
            }
            lrun[qt] += ls;
#pragma unroll
            for (int g = 0; g < 2; ++g) { u32x4 w; w.x = cvt_pk_bf16(S[qt][2 * g][0], S[qt][2 * g][1]); w.y = cvt_pk_bf16(S[qt][2 * g][2], S[qt][2 * g][3]);
                w.z = cvt_pk_bf16(S[qt][2 * g + 1][0], S[qt][2 * g + 1][1]); w.w = cvt_pk_bf16(S[qt][2 * g + 1][2], S[qt][2 * g + 1][3]);
                Pf[qt][g] = __builtin_bit_cast(bf16x8, w); }
        }
    };
    for (int t = 0; t < nt; t += 2) {
        const int b0 = t & 3, b1 = (t + 1) & 3, b2 = (t + 2) & 3, b3 = (t + 3) & 3;
        const bool more = t + 2 < nt;
        if (more) gload((t + 2) * 64);
        sphase(lds + b0 * BUFB, t * 64);
        pv(lds + b0 * BUFB + KBYTES);
        if (more) { lstore(b2); gload((t + 3) * 64); }
        sphase(lds + b1 * BUFB, (t + 1) * 64);
        pv(lds + b1 * BUFB + KBYTES);
        if (more) lstore(b3);
        __syncthreads();
    }
    float inv[2];
#pragma unroll
    for (int qt = 0; qt < 2; ++qt) { float l = lrun[qt]; l += __shfl_xor(l, 16); l += __shfl_xor(l, 32); inv[qt] = 1.0f / l; }
    if (MODE == 0) {
#pragma unroll
        for (int qt = 0; qt < 2; ++qt) { bf16_t* orow = Op + (size_t)(qrow0 + qt * 16 + l15) * D + quad * 4;
#pragma unroll
            for (int eb = 0; eb < EB; ++eb) { const f32x4 y = O[qt][eb] * inv[qt];
                u32x2 w; w.x = cvt_pk_bf16(y.x, y.y); w.y = cvt_pk_bf16(y.z, y.w); *(u32x2*)(orow + eb * 16) = w; } }
    } else {
        LAS f32x4* X = (LAS f32x4*)lds + (size_t)(wid & 3) * (2 * EB * 64) + lane;
        if (sub == 1) {
            float s01 = 0.f, s23 = 0.f;
            for (int i = 0; i < 64; ++i) { s01 += lamp[i] * lamp[64 + i]; s23 += lamp[128 + i] * lamp[192 + i]; }
            const float lam = expf(s01) - expf(s23) + lam_init;
#pragma unroll
            for (int qt = 0; qt < 2; ++qt)
#pragma unroll
                for (int eb = 0; eb < EB; ++eb) X[(qt * EB + eb) * 64] = O[qt][eb] * (lam * inv[qt]);
        }
        __syncthreads();
        if (sub == 0) {
#pragma unroll
            for (int qt = 0; qt < 2; ++qt) {
                f32x4 dv[EB]; float ss = 0.f;
#pragma unroll
#ifdef T_NOX
                for (int eb = 0; eb < EB; ++eb) { dv[eb] = O[qt][eb] * inv[qt];
#else
                for (int eb = 0; eb < EB; ++eb) { dv[eb] = O[qt][eb] * inv[qt] - X[(qt * EB + eb) * 64];
#endif
                    ss += (dv[eb].x * dv[eb].x + dv[eb].y * dv[eb].y) + (dv[eb].z * dv[eb].z + dv[eb].w * dv[eb].w); }
                ss += __shfl_xor(ss, 16); ss += __shfl_xor(ss, 32);
                const float r = outscale / sqrtf(ss * (1.0f / (EB * 16)) + LN_EPS);
                bf16_t* orow = Op + (size_t)(qrow0 + qt * 16 + l15) * D + quad * 4;
#pragma unroll
                for (int eb = 0; eb < EB; ++eb) { const f32x4 gsl = *(const f32x4*)(subln + eb * 16 + quad * 4); const f32x4 y = dv[eb] * r * gsl;
                    u32x2 w; w.x = cvt_pk_bf16(y.x, y.y); w.y = cvt_pk_bf16(y.z, y.w); *(u32x2*)(orow + eb * 16) = w; }
            }
        }
        __syncthreads();
    }
}

__device__ __forceinline__ void diffattn_phase(const Params& P, LAS unsigned char* lds, const bf16_t* p, bf16_t* mix, int layer, int variant = 0) {
    const int jj = layer / 3;
    const float* lp = P.attn_lambda + jj * 256;
    const float lam_init = layer == 0 ? 0.200000000f : (layer == 1 ? 0.355509068f : (layer == 2 ? 0.470713018f : 0.556058204f));
    LAS float* btab = (LAS float*)(lds + 4 * (64 * 272 + 128 * 144));
    int cur_h = -1;
    const bool swz = gridDim.x == 256;
    for (int it = 0, item = blockIdx.x; swz ? it < 6 : item < 4 * 6 * 64; ++it, item += gridDim.x) {
        const int bh = swz ? (int)(blockIdx.x & 7) * 3 + (it >> 1) : item >> 6;
        const int qb = swz ? (int)(blockIdx.x >> 3) + 32 * (it & 1) : item & 63;
        const int b = bh / 6, h = bh % 6;
        if (h != cur_h) { __syncthreads();
            for (int i = otid(); i < 512; i += 512) btab[i] = P.rel_bias[t5_bucket(i - 256) * 6 + h] * LOG2E;
            cur_h = h; __syncthreads(); }
        const size_t tok0 = (size_t)b * SEQ + qb * 128;
        flash_item<1>(variant, lds, p + tok0 * 2560 + h * 128, 2560, p + (size_t)b * SEQ * 2560 + MIXW + h * 128, 2560, p + (size_t)b * SEQ * 2560 + 2 * MIXW + h * 128, 2560,
                      SEQ, qb * 128, btab, mix + tok0 * D + h * 128, lp, lam_init, P.attn_subln + jj * 128, 1.0f - lam_init);
    }
}
__device__ __forceinline__ void memattn_phase(const Params& P, LAS unsigned char* lds, const bf16_t* p, int ldp, int xq0, bf16_t* mix, int layer, int first = 0, int stride = 0) {
    const bf16_t* kvm = (const bf16_t*)(P.ws + WS_KVM);
    if (stride == 0) { first = blockIdx.x; stride = gridDim.x; }
    for (int item = first; item < 128 * 4; item += stride) {
        const int h = item & 3, qb = item >> 2; const size_t tok0 = (size_t)qb * 256; const int b = qb >> 5;
        const bf16_t* kp = kvm + (size_t)b * 256 * 2048 + layer * 512 + h * 64;
        flash_item<0>(0, lds, p + tok0 * ldp + xq0 + h * 64, ldp, kp, 2048, kp + 256, 2048, 256, 0, nullptr, mix + tok0 * D + MIXW + h * 64, nullptr, 0.f, nullptr, 1.0f);
    }
}

__device__ __forceinline__ void hgrn_prep(const Params& P, bf16_t* p, bf16_t* QF, float* elast, int layer) {
    const size_t total = (size_t)4 * 128 * 384;
    for (size_t it = (size_t)blockIdx.x * 512 + otid(); it < total; it += (size_t)gridDim.x * 512) {
        const int cp = (int)(it % 384), chunk = (int)((it / 384) % 128), b = (int)(it / (384 * 128));
        const int c = cp * 2;
        float lb[2][2];
#pragma unroll
        for (int d = 0; d < 2; ++d)
#pragma unroll
            for (int e = 0; e < 2; ++e) { float den = 0.f, num = 0.f;
                for (int i = 0; i < 4; ++i) { const float ev = expf(P.hgrn_lb[(size_t)i * 2 * MIXW + d * MIXW + c + e]); den += ev; if (i >= 1 && i <= layer) num += ev; }
                lb[d][e] = num / den; }
        bf16_t* base = p + ((size_t)b * SEQ + chunk * 64) * 4096 + c;
        bf16_t* qf = QF + ((size_t)b * SEQ + chunk * 64) * MIXW + c;
        const float QS = 0.08838834764831845f;
        float e0 = 1.f, e1 = 1.f;
        for (int t = 0; t < 64; ++t) {
            const unsigned qw = *(const unsigned*)(base + (size_t)t * 4096), zw = *(const unsigned*)(base + (size_t)t * 4096 + 3 * MIXW);
            const float q0 = bflo(qw), q1 = bfhi(qw), z0 = bflo(zw), z1 = bfhi(zw);
            const float sg0 = fast_sigmoid(z0), sg1 = fast_sigmoid(z1);
            e0 *= lb[0][0] + (1.f - lb[0][0]) * sg0; e1 *= lb[0][1] + (1.f - lb[0][1]) * sg1;
            *(unsigned*)(qf + (size_t)t * MIXW) = cvt_pk_bf16(fast_silu(q0) * QS * e0, fast_silu(q1) * QS * e1);
            *(unsigned*)(base + (size_t)t * 4096 + 3 * MIXW) = cvt_pk_bf16((1.f - lb[0][0]) * (1.f - sg0) * __builtin_amdgcn_rcpf(e0), (1.f - lb[0][1]) * (1.f - sg1) * __builtin_amdgcn_rcpf(e1));
        }
        { float* el = elast + ((size_t)(0 * 4 + b) * 128 + chunk) * MIXW + c; el[0] = e0; el[1] = e1; }
        e0 = 1.f; e1 = 1.f;
        for (int t = 63; t >= 0; --t) {
            const unsigned qw = *(const unsigned*)(base + (size_t)t * 4096), zw = *(const unsigned*)(base + (size_t)t * 4096 + 4 * MIXW);
            const float q0 = bflo(qw), q1 = bfhi(qw), z0 = bflo(zw), z1 = bfhi(zw);
            const float sg0 = fast_sigmoid(z0), sg1 = fast_sigmoid(z1);
            e0 *= lb[1][0] + (1.f - lb[1][0]) * sg0; e1 *= lb[1][1] + (1.f - lb[1][1]) * sg1;
            *(unsigned*)(base + (size_t)t * 4096) = cvt_pk_bf16(fast_silu(q0) * QS * e0, fast_silu(q1) * QS * e1);
            *(unsigned*)(base + (size_t)t * 4096 + 4 * MIXW) = cvt_pk_bf16((1.f - lb[1][0]) * (1.f - sg0) * __builtin_amdgcn_rcpf(e0), (1.f - lb[1][1]) * (1.f - sg1) * __builtin_amdgcn_rcpf(e1));
        }
        { float* el = elast + ((size_t)(1 * 4 + b) * 128 + chunk) * MIXW + c; el[0] = e0; el[1] = e1; }
    }
}

__device__ __forceinline__ void hgrn_scan(const Params& P, LAS unsigned char* lds, const bf16_t* p, const bf16_t* QF, const float* elast, bf16_t* mix, bf16_t* OB) {
    constexpr int RP = 272, TP = 136;
    constexpr int OQ = 0, OK = 64 * RP, OKT = 2 * 64 * RP, OVT = OKT + 128 * TP, INB = OVT + 32 * TP;
    constexpr int SBB = 32 * RP, OSB = 0, INB0 = 2 * SBB;
    const int tid = otid(), lane = tid & 63, wid = tid >> 6, l15 = lane & 15, quad = lane >> 4;
    const int keg = (wid & 3) * 4 + (lane & 3), kpair = (wid >> 2) * 16 + (lane >> 2);
    const int veg = lane & 3, vpair = wid * 16 + (lane >> 2); const bool vact = wid < 2;
    const int vb = wid & 1, tb = wid >> 1;
    for (int item = blockIdx.x; item < 192; item += gridDim.x) {
        const int dir = item / 96, r = item % 96, b = r / 24, h = (r % 24) >> 2, vs = r & 3;
        const bf16_t* qsrc = dir == 0 ? QF + (size_t)b * SEQ * MIXW + h * 128 : p + (size_t)b * SEQ * 4096 + h * 128;
        const int ldqs = dir == 0 ? MIXW : 4096;
        const bf16_t* ksrc = p + (size_t)b * SEQ * 4096 + (3 + dir) * MIXW + h * 128;
        const bf16_t* vsrc = p + (size_t)b * SEQ * 4096 + MIXW + h * 128 + vs * 32;
        const float* elp = elast + (size_t)(dir * 4 + b) * 128 * MIXW + h * 128 + wid * 16 + l15;
        bf16_t* osrc = dir == 0 ? mix + (size_t)b * SEQ * D + h * 128 + vs * 32 : OB + (size_t)b * SEQ * MIXW + h * 128 + vs * 32;
        const int ldo = dir == 0 ? D : MIXW;
        u32x4 qreg[2], kreg[2], vreg[2]; float elreg = 0.f;
        auto gload = [&](int chunk) {
            const size_t t0 = (size_t)chunk * 64;
#pragma unroll
            for (int i = 0; i < 2; ++i) { const int c = tid + i * 512, ch = c & 15, row = c >> 4; qreg[i] = *(const u32x4*)(qsrc + (t0 + row) * ldqs + ch * 8); }
            kreg[0] = *(const u32x4*)(ksrc + (t0 + 2 * kpair) * 4096 + keg * 8); kreg[1] = *(const u32x4*)(ksrc + (t0 + 2 * kpair + 1) * 4096 + keg * 8);
            if (vact) { vreg[0] = *(const u32x4*)(vsrc + (t0 + 2 * vpair) * 4096 + veg * 8); vreg[1] = *(const u32x4*)(vsrc + (t0 + 2 * vpair + 1) * 4096 + veg * 8); }
            elreg = elp[(size_t)chunk * MIXW];
        };
        auto lstore = [&](int buf) {
            LAS unsigned char* bb = lds + INB0 + buf * INB;
#pragma unroll
            for (int i = 0; i < 2; ++i) { const int c = tid + i * 512, ch = c & 15, row = c >> 4; *(LAS u32x4*)(bb + OQ + row * RP + ch * 16) = qreg[i]; }
            *(LAS u32x4*)(bb + OK + (2 * kpair) * RP + keg * 16) = kreg[0]; *(LAS u32x4*)(bb + OK + (2 * kpair + 1) * RP + keg * 16) = kreg[1];
            { const unsigned a[4] = {kreg[0].x, kreg[0].y, kreg[0].z, kreg[0].w}, c2[4] = {kreg[1].x, kreg[1].y, kreg[1].z, kreg[1].w};
#pragma unroll
              for (int i = 0; i < 4; ++i) { *(LAS unsigned*)(bb + OKT + (keg * 8 + 2 * i) * TP + kpair * 4) = (a[i] & 0xffffu) | (c2[i] << 16);
                  *(LAS unsigned*)(bb + OKT + (keg * 8 + 2 * i + 1) * TP + kpair * 4) = (a[i] >> 16) | (c2[i] & 0xffff0000u); } }
            if (vact) { const unsigned a[4] = {vreg[0].x, vreg[0].y, vreg[0].z, vreg[0].w}, c2[4] = {vreg[1].x, vreg[1].y, vreg[1].z, vreg[1].w};
#pragma unroll
              for (int i = 0; i < 4; ++i) { *(LAS unsigned*)(bb + OVT + (veg * 8 + 2 * i) * TP + vpair * 4) = (a[i] & 0xffffu) | (c2[i] << 16);
                  *(LAS unsigned*)(bb + OVT + (veg * 8 + 2 * i + 1) * TP + vpair * 4) = (a[i] >> 16) | (c2[i] & 0xffff0000u); } }
        };
        for (int i = tid; i < SBB / 4; i += 512) *(LAS unsigned*)(lds + OSB + i * 4) = 0u;
        f32x4 Sacc[2] = {(f32x4){0.f, 0.f, 0.f, 0.f}, (f32x4){0.f, 0.f, 0.f, 0.f}};
        gload(dir == 0 ? 0 : 127); lstore(0); float elcur = elreg; __syncthreads();
        for (int step = 0; step < 128; ++step) {
            const int chunk = dir == 0 ? step : 127 - step;
            LAS unsigned char* bb = lds + INB0 + (step & 1) * INB; LAS unsigned char* sbc = lds + OSB + (step & 1) * SBB; LAS unsigned char* sbn = lds + OSB + ((step + 1) & 1) * SBB;
            if (step + 1 < 128) gload(dir == 0 ? step + 1 : 126 - step);
            bf16x8 Qfr[4];
#pragma unroll
            for (int ks = 0; ks < 4; ++ks) Qfr[ks] = *(const LAS bf16x8*)(bb + OQ + (tb * 16 + l15) * RP + ks * 64 + quad * 16);
            f32x4 oacc = (f32x4){0.f, 0.f, 0.f, 0.f};
#pragma unroll
#ifndef T_NOSTATE
            for (int ks = 0; ks < 4; ++ks) { const bf16x8 a = *(const LAS bf16x8*)(sbc + (vb * 16 + l15) * RP + ks * 64 + quad * 16); oacc = mfma16(a, Qfr[ks], oacc); }
#endif
            f32x4 A4[4];
#pragma unroll
            for (int sb = 0; sb < 4; ++sb) { A4[sb] = (f32x4){0.f, 0.f, 0.f, 0.f};
                const bool need = dir == 0 ? (sb <= tb) : (sb >= tb);
                if (need) {
#pragma unroll
                    for (int ks = 0; ks < 4; ++ks) { const bf16x8 a = *(const LAS bf16x8*)(bb + OK + (sb * 16 + l15) * RP + ks * 64 + quad * 16); A4[sb] = mfma16(a, Qfr[ks], A4[sb]); }
                    if (sb == tb) {
#pragma unroll
                        for (int j = 0; j < 4; ++j) { const int s = quad * 4 + j; const bool keep = dir == 0 ? (s <= l15) : (s >= l15); A4[sb][j] = keep ? A4[sb][j] : 0.f; }
                    }
                } }
#ifndef T_NOINTRA
#pragma unroll
            for (int g = 0; g < 2; ++g) { u32x4 w; w.x = cvt_pk_bf16(A4[2 * g][0], A4[2 * g][1]); w.y = cvt_pk_bf16(A4[2 * g][2], A4[2 * g][3]);
                w.z = cvt_pk_bf16(A4[2 * g + 1][0], A4[2 * g + 1][1]); w.w = cvt_pk_bf16(A4[2 * g + 1][2], A4[2 * g + 1][3]);
                const LAS unsigned char* vp = bb + OVT + (vb * 16 + l15) * TP + (32 * g + 4 * quad) * 2;
                const bf16x8 a = mk8(*(const LAS u32x2*)vp, *(const LAS u32x2*)(vp + 32));
                oacc = mfma16(a, __builtin_bit_cast(bf16x8, w), oacc); }
#endif
            { u32x2 w; w.x = cvt_pk_bf16(oacc[0], oacc[1]); w.y = cvt_pk_bf16(oacc[2], oacc[3]);
              *(u32x2*)(osrc + ((size_t)chunk * 64 + tb * 16 + l15) * ldo + vb * 16 + quad * 4) = w; }
#pragma unroll
            for (int v2 = 0; v2 < 2; ++v2) {
#pragma unroll
                for (int g = 0; g < 2; ++g) { const LAS unsigned char* vp = bb + OVT + (v2 * 16 + l15) * TP + (32 * g + 8 * quad) * 2;
                    const LAS unsigned char* kp = bb + OKT + (wid * 16 + l15) * TP + (32 * g + 8 * quad) * 2;
                    Sacc[v2] = mfma16(mk8(*(const LAS u32x2*)vp, *(const LAS u32x2*)(vp + 8)), mk8(*(const LAS u32x2*)kp, *(const LAS u32x2*)(kp + 8)), Sacc[v2]); }
                Sacc[v2] = Sacc[v2] * elcur;
#pragma unroll
                for (int j = 0; j < 4; ++j) *(LAS unsigned short*)(sbn + (v2 * 16 + quad * 4 + j) * RP + (wid * 16 + l15) * 2) = (unsigned short)(cvt_pk_bf16(Sacc[v2][j], 0.f) & 0xffffu);
            }
            if (step + 1 < 128) { lstore((step + 1) & 1); elcur = elreg; }
            __syncthreads();
        }
    }
}
__device__ __forceinline__ void hgrn_combine(const Params& P, const bf16_t* p, bf16_t* mix, const bf16_t* OB) {
    const int lane = otid() & 63, wid = otid() >> 6, grp = lane >> 4, l15 = lane & 15;
    const size_t total = (size_t)NTOK * 6 / 4;
    for (size_t it = (size_t)blockIdx.x * 8 + wid; it < total; it += (size_t)gridDim.x * 8) {
        const size_t pair = it * 4 + grp; const size_t tok = pair / 6; const int h = (int)(pair % 6); const int c = h * 128 + l15 * 8;
        float a[8], bq[8], gg[8], o[8];
        unpack8(*(const u32x4*)(mix + tok * D + c), a); unpack8(*(const u32x4*)(OB + tok * MIXW + c), bq); unpack8(*(const u32x4*)(p + tok * 4096 + 2 * MIXW + c), gg);
        float ss = 0.f;
#pragma unroll
        for (int i = 0; i < 8; ++i) { o[i] = a[i] + bq[i]; ss += o[i] * o[i]; }
        ss += __shfl_xor(ss, 1); ss += __shfl_xor(ss, 2); ss += __shfl_xor(ss, 4); ss += __shfl_xor(ss, 8);
        const float r = 1.0f / sqrtf(ss * (1.0f / 128.f) + LN_EPS);
        const f32x4 w0 = *(const f32x4*)(P.hgrn_norm + c), w1 = *(const f32x4*)(P.hgrn_norm + c + 4);
        const float wn[8] = {w0.x, w0.y, w0.z, w0.w, w1.x, w1.y, w1.z, w1.w};
#pragma unroll
        for (int i = 0; i < 8; ++i) o[i] = o[i] * r * wn[i] * fast_silu(gg[i]);
        u32x4 ow; ow.x = cvt_pk_bf16(o[0], o[1]); ow.y = cvt_pk_bf16(o[2], o[3]); ow.z = cvt_pk_bf16(o[4], o[5]); ow.w = cvt_pk_bf16(o[6], o[7]);
        *(u32x4*)(mix + tok * D + c) = ow;
    }
}


__device__ __forceinline__ void gsync(cg::grid_group& grid) {
#ifdef GSYNC_HEAVY
    asm volatile("s_waitcnt vmcnt(0) lgkmcnt(0)" ::: "memory");
    __syncthreads();
    if (otid() < 64) { __builtin_amdgcn_fence(__ATOMIC_RELEASE, "agent"); asm volatile("s_waitcnt vmcnt(0)" ::: "memory"); }
    __syncthreads();
    grid.sync();
    __builtin_amdgcn_fence(__ATOMIC_ACQUIRE, "agent");
    asm volatile("s_waitcnt vmcnt(0)" ::: "memory");
    __syncthreads();
#else
    asm volatile("s_waitcnt vmcnt(0) lgkmcnt(0)" ::: "memory");
    grid.sync();
#endif
}
#ifdef DBG_STOP
__device__ __forceinline__ void dbg_dump_bf16(float* out, const bf16_t* src, int ld) {
    for (size_t i = (size_t)blockIdx.x * 512 + otid(); i < (size_t)NTOK * D; i += (size_t)gridDim.x * 512) { const size_t t = i / D, c = i % D; float v = bf2f(src[t * ld + c]); out[i] = (v == v && fabsf(v) < 1e30f) ? v : 12345.f; }
}
__device__ __forceinline__ void dbg_san(float* out) {
    for (size_t i = (size_t)blockIdx.x * 512 + otid(); i < (size_t)NTOK * D; i += (size_t)gridDim.x * 512) { float v = out[i]; out[i] = (v == v && fabsf(v) < 1e30f) ? v : 12345.f; }
}
#define DBG_AT(n, code) if (DBG_STOP == (n)) { gsync(grid); code; return; }
#else
#define DBG_AT(n, code)
#endif
#ifdef UNFUSED_GATE
constexpr int NPH = 1 + 4 * 12 + 2;
#else
constexpr int NPH = 1 + 4 * 8 + 2;
#endif
__global__ void __launch_bounds__(512) mega_fwd(Params P, int lo, int hi, int variant) {
    extern __shared__ __attribute__((aligned(16))) unsigned char shm[];
    LAS unsigned char* lds = (LAS unsigned char*)shm;
    cg::grid_group grid = cg::this_grid();
    unsigned char* ws = P.ws;
    bf16_t* Wt_in = (bf16_t*)(ws + WS_WIN); bf16_t* Wt_o = (bf16_t*)(ws + WS_WO); bf16_t* Wt_up = (bf16_t*)(ws + WS_WUP); bf16_t* Wt_dn = (bf16_t*)(ws + WS_WDN);
    bf16_t* xb = (bf16_t*)(ws + WS_XB); bf16_t* pbuf = (bf16_t*)(ws + WS_BIG); bf16_t* mix = (bf16_t*)(ws + WS_BIG + BIG_MIX);
    bf16_t* gbuf = (bf16_t*)(ws + WS_BIG); bf16_t* ubuf = (bf16_t*)(ws + WS_BIG + BIG_U); bf16_t* OB = (bf16_t*)(ws + WS_OB);
    float* elast = (float*)(ws + WS_ELAST); float* lnst = (float*)(ws + WS_LNST);
#ifdef TIMING_DUMMY
    if (lo < 0) {
        float* sf = (float*)(ws + WS_BIG + BIG_U); bf16_t* sb = mix;
        if (variant == 10) ln_phase(sf, sb, P.ln_gain, P.ln_bias, lnst, false);
        else if (variant == 11) hgrn_prep(P, pbuf, xb, elast, 1);
        else if (variant == 12) hgrn_combine(P, pbuf, mix, OB);
        else if (variant == 13) memattn_phase(P, lds, pbuf, 2560, 2304, mix, 0);
        else if (variant == 14) convert_layer(P, 1, lds);
        else if (variant == 15) { EpiResid E; E.io = sf; E.xin = P.x; E.stats = nullptr; E.lg = nullptr; E.lb = nullptr; run_gemm(lds, mix, Wt_o, NTOK, D, D, E); }
        else if (variant == 16) { EpiResid E; E.io = sf; E.xin = P.x; E.stats = nullptr; E.lg = nullptr; E.lb = nullptr; run_gemm(lds, gbuf, Wt_dn, NTOK, D, DFF, E); }
        else if (variant == 17) shortconv_phase(pbuf, 2560, mix, P.conv_w);
        else if (variant == 18) { convert_prologue(P, lds); }
        return;
    }
#endif
    int ph = 0;
#define SEG(...) { if (ph >= lo && ph < hi) { __VA_ARGS__; if (ph + 1 < hi) gsync(grid); } ++ph; }
    SEG(convert_prologue(P, lds); convert_layer(P, 0, lds))
    for (int layer = 0; layer < 4; ++layer) {
        const int kind = layer % 3; const int NIN = kind == 1 ? 4096 : 2560;
        SEG(if (layer == 0) { EpiBf16P E; E.O = (bf16_t*)(ws + WS_KVM); E.ldc = 2048; run_gemm(lds, (const bf16_t*)(ws + WS_MEMB), (const bf16_t*)(ws + WS_WKV), 1024, 2048, D, E); }
            { EpiBf16P E; E.O = pbuf; E.ldc = NIN; run_gemm(lds, xb, Wt_in, NTOK, NIN, D, E); })
        if (kind == 1) {
            SEG(hgrn_prep(P, pbuf, xb, elast, layer))
            SEG(if ((int)gridDim.x > 192 && (int)blockIdx.x >= 192) memattn_phase(P, lds, pbuf, NIN, NIN - 256, mix, layer, (int)blockIdx.x - 192, (int)gridDim.x - 192);
                else hgrn_scan(P, lds, pbuf, xb, elast, mix, OB))
        }
        SEG(if (kind == 0) diffattn_phase(P, lds, pbuf, mix, layer, variant);
            else if (kind == 2) shortconv_phase(pbuf, 2560, mix, P.conv_w + (size_t)(layer / 3) * 3 * MIXW);
            else hgrn_combine(P, pbuf, mix, OB);
            __syncthreads();
            if (kind != 1 || (int)gridDim.x <= 192) memattn_phase(P, lds, pbuf, NIN, NIN - 256, mix, layer))
        SEG({ EpiResid E; E.io = P.out; E.xin = layer == 0 ? P.x : P.out; E.stats = layer == 0 ? nullptr : lnst; E.lg = P.ln_gain + (size_t)(layer == 0 ? 0 : layer - 1) * 2 * D + D; E.lb = P.ln_bias + (size_t)(layer == 0 ? 0 : layer - 1) * 2 * D + D;
              run_gemm(lds, mix, Wt_o, NTOK, D, D, E); })
        SEG(ln_phase(P.out, xb, P.ln_gain + (size_t)layer * 2 * D, P.ln_bias + (size_t)layer * 2 * D, lnst, false))
#ifdef UNFUSED_GATE
        for (int part = 0; part < 3; ++part) {
            const int tile0 = part * 8, ntile = part < 2 ? 8 : 6;
            SEG({ EpiBf16P E; E.O = ubuf; E.ldc = ntile * 256; run_gemm(lds, xb, Wt_up + (size_t)tile0 * 256 * D, NTOK, ntile * 256, D, E); })
            SEG(gate_phase(ubuf, ntile * 256, tile0, ntile, gbuf, P.ffn_conv + (size_t)layer * 3 * 2 * DFF))
        }
#else
        SEG({ EpiGate E; E.g = gbuf; E.edge = (float*)ubuf; E.cw = P.ffn_conv + (size_t)layer * 3 * 2 * DFF; E.xl = lds + 131072; run_gemm(lds, xb, Wt_up, NTOK, 2 * DFF, D, E); })
        SEG(gate_fixup((const float*)ubuf, gbuf, P.ffn_conv + (size_t)layer * 3 * 2 * DFF))
#endif
        SEG({ EpiResid E; E.io = P.out; E.xin = P.out; E.stats = lnst; E.lg = P.ln_gain + (size_t)layer * 2 * D; E.lb = P.ln_bias + (size_t)layer * 2 * D; run_gemm(lds, gbuf, Wt_dn, NTOK, D, DFF, E); })
        SEG(ln_phase(P.out, xb, P.ln_gain + (size_t)layer * 2 * D + D, P.ln_bias + (size_t)layer * 2 * D + D, lnst, layer == 3);
            if (layer + 1 < 4) convert_layer(P, layer + 1, lds))
    }
#undef SEG
}


#ifdef DBG_LAST
__global__ void dbg_dump_k(Params P, int which) {
    float* out = P.out;
    for (size_t i = (size_t)blockIdx.x * blockDim.x + threadIdx.x; i < (size_t)NTOK * D; i += (size_t)gridDim.x * blockDim.x) {
        const size_t t = i / D, c = i % D; float v;
        if (which == 0) v = out[i];
        else if (which == 1) v = bf2f(((const bf16_t*)(P.ws + WS_XB))[i]);
        else if (which == 2) v = bf2f(((const bf16_t*)(P.ws + WS_BIG))[t * 2560 + c]);
        else if (which == 3) v = bf2f(((const bf16_t*)(P.ws + WS_BIG))[t * 4096 + c]);
        else if (which == 4) v = bf2f(((const bf16_t*)(P.ws + WS_BIG + BIG_MIX))[i]);
        else if (which == 5) v = bf2f(((const bf16_t*)(P.ws + WS_WIN))[t * 128 + c]);
        else if (which == 6) v = bf2f(((const bf16_t*)(P.ws + WS_BIG))[t * 4096 + 2304 + c]);
        else if (which == 12) v = bf2f(((const bf16_t*)(P.ws + WS_BIG + BIG_MIX))[t * 1024 + (c % 768)]);
        else if (which == 13) v = bf2f(((const bf16_t*)(P.ws + WS_BIG + BIG_MIX))[t * 1024 + 768 + (c % 256)]);
        else if (which == 8) v = bf2f(((const bf16_t*)(P.ws + WS_BIG))[t * 2560 + 1024 + c]);
        else if (which == 9) v = bf2f(((const bf16_t*)(P.ws + WS_BIG))[t * 2560 + 1536 + c]);
        else if (which == 10) v = bf2f(((const bf16_t*)(P.ws + WS_KVM))[(t % 1024) * 2048 + c]);
        else if (which == 11) v = bf2f(((const bf16_t*)(P.ws + WS_KVM))[(t % 1024) * 2048 + 1024 + c]);
        else v = bf2f(((const bf16_t*)(P.ws + WS_OB))[t * 768 + (c % 768)]);
        out[i] = (v == v && fabsf(v) < 1e30f) ? v : 12345.f;
    }
}
#endif
#ifndef N_LAUNCHES
#define N_LAUNCHES 1
#endif
extern "C" void kernel_launch(void* const* d_in, const int* in_sizes, int n_in, void* d_out, int out_size, void* d_ws, size_t ws_size, hipStream_t stream) {
    static int grid_blocks = 0;
    if (grid_blocks == 0) {
        int dev = 0, cus = 0, per_cu = 0;
        (void)hipGetDevice(&dev); (void)hipDeviceGetAttribute(&cus, hipDeviceAttributeMultiprocessorCount, dev);
        (void)hipFuncSetAttribute((const void*)mega_fwd, hipFuncAttributeMaxDynamicSharedMemorySize, LDS_BYTES);
        (void)hipOccupancyMaxActiveBlocksPerMultiprocessor(&per_cu, (const void*)mega_fwd, 512, LDS_BYTES);
        if (per_cu < 1) per_cu = 1;
        grid_blocks = cus * per_cu;
        if (grid_blocks > 256) grid_blocks = 256;
        if (ws_size < WS_END || n_in != 18) { fprintf(stderr, "kernel_launch: unexpected ws_size %zu or n_in %d\n", ws_size, n_in); grid_blocks = -1; }
    }
    if (grid_blocks < 0) return;
    Params P{};
    P.x = (const float*)d_in[0]; P.mem = (const float*)d_in[1]; P.rel_bias = (const float*)d_in[2]; P.attn_w_in = (const float*)d_in[3]; P.attn_lambda = (const float*)d_in[4];
    P.attn_subln = (const float*)d_in[5]; P.hgrn_w_in = (const float*)d_in[6]; P.hgrn_lb = (const float*)d_in[7]; P.hgrn_norm = (const float*)d_in[8]; P.conv_w_in = (const float*)d_in[9];
    P.conv_w = (const float*)d_in[10]; P.mem_w_kv = (const float*)d_in[11]; P.w_o = (const float*)d_in[12]; P.ln_gain = (const float*)d_in[13]; P.ln_bias = (const float*)d_in[14];
    P.ffn_w_up = (const float*)d_in[15]; P.ffn_conv = (const float*)d_in[16]; P.ffn_w_down = (const float*)d_in[17];
    P.out = (float*)d_out; P.ws = (unsigned char*)d_ws;
    if (N_LAUNCHES == 1) {
        int lo = 0, hi = NPH, var0 = 0;
        void* args[] = {&P, &lo, &hi, &var0};
        hipError_t e = hipLaunchCooperativeKernel((const void*)mega_fwd, dim3(grid_blocks), dim3(512), args, LDS_BYTES, stream);
        if (e != hipSuccess) fprintf(stderr, "cooperative launch failed: %s (grid %d)\n", hipGetErrorString(e), grid_blocks);
    } else {
#ifdef DBG_LAST
        for (int ph = 0; ph <= DBG_LAST; ++ph) hipLaunchKernelGGL(mega_fwd, dim3(grid_blocks), dim3(512), LDS_BYTES, stream, P, ph, ph + 1, 0);
        hipLaunchKernelGGL(dbg_dump_k, dim3(1024), dim3(256), 0, stream, P, DBG_BUF);
#else
#ifdef TIMING_DUMMY
        for (int r = 0; r < 4; ++r) hipLaunchKernelGGL(mega_fwd, dim3(grid_blocks), dim3(512), LDS_BYTES, stream, P, -1, 0, TIMING_DUMMY);
#endif
        for (int ph = 0; ph < NPH; ++ph) {
#ifdef DUP_PH
            if (ph == DUP_PH) for (int r = 0; r < DUP_N; ++r) hipLaunchKernelGGL(mega_fwd, dim3(grid_blocks), dim3(512), LDS_BYTES, stream, P, ph, ph + 1, DUP_VAR);
#endif
            hipLaunchKernelGGL(mega_fwd, dim3(grid_blocks), dim3(512), LDS_BYTES, stream, P, ph, ph + 1, 0);
#ifdef DUP_PH

#endif
        }
#endif
    }
}
```

```cpp
#include <hip/hip_runtime.h>
#include <hip/hip_cooperative_groups.h>
#include <cstdio>
namespace cg = cooperative_groups;

__device__ __forceinline__ int otid() { int t = threadIdx.x; asm volatile("" : "+v"(t)); return t; }
#ifndef PG8_WGM
#define PG8_WGM 8
#endif
#ifndef PG8_AUX
#define PG8_AUX 0
#endif
namespace pg8 {
#define PG8_LAS __attribute__((address_space(3)))
typedef unsigned short bf16_t;
typedef short bf16x8 __attribute__((ext_vector_type(8)));
typedef float f32x4 __attribute__((ext_vector_type(4)));
typedef unsigned u32x4 __attribute__((ext_vector_type(4)));
constexpr int BM = 256, BK = 64, HALF = 128, HTB = HALF * BK * 2  , STAGE_BYTES = 8 * HTB, NXCD = 8, WGM = PG8_WGM;

__host__ __device__ __forceinline__ int lds_byte(int r, int c) { const int st = (r >> 4) * 2 + (c >> 5), rr = r & 15, cc = c & 31, ob = rr * 64 + cc * 2; return st * 1024 + (ob ^ (((ob >> 9) & 1) << 5)); }
__host__ __device__ __forceinline__ void stage_rc(int b, int& R, int& C) { const int st = b / 1024, sb = b % 1024, swz = sb ^ (((sb >> 9) & 1) << 5); R = (st >> 1) * 16 + swz / 64; C = (st & 1) * 32 + (swz % 64) / 2; }
__host__ __device__ __forceinline__ int perm32(int rho) { const int n = rho >> 4, i = rho & 15; return 8 * (i >> 2) + 4 * n + (i & 3); }
struct Unit { int pm, pn; };
struct Gemm { const bf16_t* A; const bf16_t* Bt; int M, N, K; };
struct StaticOrder {
    int nM, nN, nwg, G, c;
    __host__ __device__ void init(int M, int N, int G_, int c_) { nM = M / BM; nN = N / BM; nwg = nM * nN; G = G_; c = c_; }
    __host__ __device__ bool next(int i, Unit& u) const {
        const long L = (long)i * G + c; if (L >= nwg) return false;
        int wgid = (int)L; { const int q = nwg / NXCD, r = nwg % NXCD, xcd = wgid % NXCD, off = wgid / NXCD; wgid = (xcd < r ? xcd * (q + 1) : r * (q + 1) + (xcd - r) * q) + off; }
        const int nig = WGM * nN, gid = wgid / nig, fm = gid * WGM, gsz = (nM - fm) < WGM ? (nM - fm) : WGM;
        u.pm = fm + ((wgid % nig) % gsz); u.pn = (wgid % nig) / gsz; return true;
    }
    __device__ __forceinline__ void a_ready(const Unit&) const {}
    __device__ __forceinline__ void done(const Unit&) const {}
};
typedef __bf16 pg8_bf2 __attribute__((ext_vector_type(2)));
typedef float pg8_f2 __attribute__((ext_vector_type(2)));
__device__ __forceinline__ unsigned cvt_pk_bf16(float lo, float hi) { pg8_f2 v; v.x = lo; v.y = hi; return __builtin_bit_cast(unsigned, __builtin_convertvector(v, pg8_bf2)); }
template <class Epi, class Sched, bool STAMP = false>
__device__ __forceinline__ void gemm_phase(PG8_LAS unsigned char* lds, const Gemm g, const Sched& S, const Epi& E, unsigned long long* stamps) {
    const int tid = otid(), wid = __builtin_amdgcn_readfirstlane(tid >> 6), lane = tid & 63, wr = wid >> 2, wc = wid & 3, fr = lane & 15, fq = lane >> 4;
    const int K = g.K, nt = K / BK;
    int ts_lo = 0, ts_hi = 0, nts = 0; const unsigned long long rt_entry = STAMP ? (unsigned long long)wall_clock64() : 0ull;
#define PG8_STAMP() do { if (STAMP && wid == 0 && nts < 64) { const unsigned long long _c = (unsigned long long)clock64(); \
        ts_lo = (lane == nts) ? (int)(unsigned)_c : ts_lo; ts_hi = (lane == nts) ? (int)(unsigned)(_c >> 32) : ts_hi; ++nts; } } while (0)
    PG8_STAMP();
    unsigned voffA[2], voffB[2];
#pragma unroll
    for (int i = 0; i < 2; ++i) { int R, C; stage_rc(tid * 16 + i * 8192, R, C); const int Rb = Epi::PERM ? ((R & ~31) + perm32(R & 31)) : R;
        voffA[i] = (unsigned)(R * K + C) * 2u; voffB[i] = (unsigned)(Rb * K + C) * 2u; }
    const size_t kstep = (size_t)(BK * 2);
    const size_t hstep = (size_t)HALF * K * 2;
    const size_t tstep = 2 * hstep;
    const unsigned ldsw = (unsigned)wid * 1024u;
    const int aoff = lds_byte(wr * 64 + fr, fq * 8), boff = lds_byte(wc * 32 + fr, fq * 8);
#define PG8_SA(b, h) (((b) * 2 + (h)) * HTB)
#define PG8_SB(b, h) ((4 + (b) * 2 + (h)) * HTB)
#define PG8_STAGE(bufoff, gbase, voff) do { _Pragma("unroll") for (int _i = 0; _i < 2; ++_i) \
        __builtin_amdgcn_global_load_lds((const unsigned*)((const char*)(gbase) + (voff)[_i]), (PG8_LAS unsigned*)(lds + (bufoff) + ldsw + _i * 8192), 16, 0, PG8_AUX); } while (0)
#define PG8_LDA(dst, b, h) do { _Pragma("unroll") for (int m = 0; m < 4; ++m) _Pragma("unroll") for (int k = 0; k < 2; ++k) dst[m][k] = *(const PG8_LAS bf16x8*)(lds + PG8_SA(b, h) + aoff + m * 2048 + k * 1024); } while (0)
#define PG8_LDB(dst, b, h) do { _Pragma("unroll") for (int n = 0; n < 2; ++n) _Pragma("unroll") for (int k = 0; k < 2; ++k) dst[n][k] = *(const PG8_LAS bf16x8*)(lds + PG8_SB(b, h) + boff + n * 2048 + k * 1024); } while (0)
#define PG8_MMA(ai, bj, At, Bt) do { __builtin_amdgcn_s_setprio(1); _Pragma("unroll") for (int m = 0; m < 4; ++m) _Pragma("unroll") for (int n = 0; n < 2; ++n) _Pragma("unroll") for (int k = 0; k < 2; ++k) \
        acc[ai][bj][m][n] = __builtin_amdgcn_mfma_f32_16x16x32_bf16(Bt[n][k], At[m][k], acc[ai][bj][m][n], 0, 0, 0); __builtin_amdgcn_s_setprio(0); } while (0)
#define PG8_WAIT_V(n) asm volatile("s_waitcnt vmcnt(" #n ")" ::: "memory")
#define PG8_WAIT_L(n) asm volatile("s_waitcnt lgkmcnt(" #n ")" ::: "memory")
#define PG8_BAR __builtin_amdgcn_s_barrier()
#define PG8_SCHED __builtin_amdgcn_sched_barrier(0)
    Unit cur, nxt; int ui = 0;
    if (!S.next(0, cur)) return;
    f32x4 acc[2][2][4][2];
#pragma unroll
    for (int a = 0; a < 2; ++a)
#pragma unroll
        for (int b = 0; b < 2; ++b)
#pragma unroll
            for (int m = 0; m < 4; ++m)
#pragma unroll
                for (int n = 0; n < 2; ++n) acc[a][b][m][n] = (f32x4){0.f, 0.f, 0.f, 0.f};
    bf16x8 At[4][2], B0[2][2], B1[2][2];
    const char* cA = (const char*)g.A + (size_t)cur.pm * tstep; const char* cB = (const char*)g.Bt + (size_t)cur.pn * tstep;
    S.a_ready(cur);
    PG8_STAGE(PG8_SB(0, 0), cB, voffB); PG8_STAGE(PG8_SA(0, 0), cA, voffA); PG8_STAGE(PG8_SB(0, 1), cB + hstep, voffB); PG8_STAGE(PG8_SA(0, 1), cA + hstep, voffA);
    if (wr == 1) PG8_BAR;
    PG8_WAIT_V(4); PG8_BAR;
    PG8_STAGE(PG8_SB(1, 0), cB + kstep, voffB); PG8_STAGE(PG8_SA(1, 0), cA + kstep, voffA); PG8_STAGE(PG8_SB(1, 1), cB + hstep + kstep, voffB);
    PG8_WAIT_V(6); PG8_BAR;
    PG8_STAMP();
    for (;;) {
        const bool has_next = S.next(ui + 1, nxt);
        const char* nA = has_next ? (const char*)g.A + (size_t)nxt.pm * tstep : cA; const char* nB = has_next ? (const char*)g.Bt + (size_t)nxt.pn * tstep : cB;
        for (int t = 0; t < nt; t += 2) {
            const bool last = (t == nt - 2);
            const char* a1 = cA + (size_t)(t + 1) * kstep;
            const char* a2 = last ? nA : cA + (size_t)(t + 2) * kstep; const char* b2 = last ? nB : cB + (size_t)(t + 2) * kstep;
            const char* a3 = a2 + kstep; const char* b3 = b2 + kstep;
            if (last && has_next) S.a_ready(nxt);
            PG8_LDB(B0, 0, 0); PG8_SCHED; PG8_LDA(At, 0, 0); PG8_STAGE(PG8_SA(1, 1), a1 + hstep, voffA);
            PG8_WAIT_L(8); PG8_BAR; PG8_WAIT_L(0); PG8_MMA(0, 0, At, B0); PG8_BAR; PG8_SCHED;
            PG8_LDB(B1, 0, 1); PG8_STAGE(PG8_SB(0, 0), b2, voffB);
            PG8_BAR; PG8_WAIT_L(0); PG8_MMA(0, 1, At, B1); PG8_BAR;
            PG8_LDA(At, 0, 1); PG8_STAGE(PG8_SA(0, 0), a2, voffA);
            PG8_BAR; PG8_WAIT_L(0); PG8_MMA(1, 0, At, B0); PG8_BAR; PG8_SCHED;
            PG8_STAGE(PG8_SB(0, 1), b2 + hstep, voffB);
            PG8_WAIT_V(6); PG8_BAR; PG8_MMA(1, 1, At, B1); PG8_BAR;
            PG8_LDB(B0, 1, 0); PG8_SCHED; PG8_LDA(At, 1, 0); PG8_STAGE(PG8_SA(0, 1), a2 + hstep, voffA);
            PG8_WAIT_L(8); PG8_BAR; PG8_WAIT_L(0); PG8_MMA(0, 0, At, B0); PG8_BAR; PG8_SCHED;
            PG8_LDB(B1, 1, 1); PG8_STAGE(PG8_SB(1, 0), b3, voffB);
            PG8_BAR; PG8_WAIT_L(0); PG8_MMA(0, 1, At, B1); PG8_BAR;
            PG8_LDA(At, 1, 1); PG8_STAGE(PG8_SA(1, 0), a3, voffA);
            PG8_BAR; PG8_WAIT_L(0); PG8_MMA(1, 0, At, B0); PG8_BAR; PG8_SCHED;
            PG8_STAGE(PG8_SB(1, 1), b3 + hstep, voffB);
            PG8_WAIT_V(6); PG8_BAR; PG8_MMA(1, 1, At, B1); PG8_BAR;
        }
        PG8_STAMP();
        if constexpr (!Epi::AFTER_DRAIN) { E(acc, cur, wr, wc, fr, fq); S.done(cur); }
        PG8_STAMP();
        if (!has_next) break;
#pragma unroll
        for (int a = 0; a < 2; ++a)
#pragma unroll
            for (int b = 0; b < 2; ++b)
#pragma unroll
                for (int m = 0; m < 4; ++m)
#pragma unroll
                    for (int n = 0; n < 2; ++n) acc[a][b][m][n] = (f32x4){0.f, 0.f, 0.f, 0.f};
        cur = nxt; cA = nA; cB = nB; ++ui;
    }
    PG8_WAIT_V(0);
    if (wr == 0) PG8_BAR;
    PG8_BAR;
    if constexpr (Epi::AFTER_DRAIN) { E.fused(acc, cur, wr, wc, fr, fq, lds, wid, lane); S.done(cur); }
    PG8_STAMP();
    if (STAMP && wid == 0) { stamps[lane] = lane < nts ? (((unsigned long long)(unsigned)ts_hi << 32) | (unsigned)ts_lo) : 0ull;
        if (lane == 62) stamps[62] = rt_entry; if (lane == 63) stamps[63] = (unsigned long long)wall_clock64(); }
#undef PG8_STAMP
#undef PG8_SA
#undef PG8_SB
#undef PG8_STAGE
#undef PG8_LDA
#undef PG8_LDB
#undef PG8_MMA
#undef PG8_WAIT_V
#undef PG8_WAIT_L
#undef PG8_BAR
#undef PG8_SCHED
}
}

using pg8::bf16_t; using pg8::bf16x8; using pg8::f32x4; using pg8::u32x4; using pg8::cvt_pk_bf16;
#define LAS PG8_LAS
typedef unsigned u32x2 __attribute__((ext_vector_type(2)));

constexpr int D = 1024, NTOK = 32768, SEQ = 8192, MIXW = 768, DFF = 2816;
constexpr float ALPHA = 1.6817928305074290f, LN_EPS = 1e-5f, LOG2E = 1.4426950408889634f;
constexpr size_t MiB = 1048576;
constexpr size_t WS_WIN = 0, WS_WO = 8 * MiB, WS_WUP = 10 * MiB, WS_WDN = 21 * MiB, WS_WKV = 27 * MiB, WS_MEMB = 31 * MiB, WS_KVM = 33 * MiB,
                 WS_ELAST = 37 * MiB, WS_XB = 40 * MiB, WS_BIG = 104 * MiB, WS_OB = 424 * MiB, WS_LNST = 472 * MiB, WS_END = 473 * MiB;
constexpr size_t BIG_MIX = 256 * MiB, BIG_U = 176 * MiB;
constexpr int LDS_BYTES = 4 * (64 * 272 + 128 * 144) + 2048;

struct Params {
    const float *x, *mem, *rel_bias, *attn_w_in, *attn_lambda, *attn_subln, *hgrn_w_in, *hgrn_lb, *hgrn_norm, *conv_w_in, *conv_w, *mem_w_kv, *w_o,
                *ln_gain, *ln_bias, *ffn_w_up, *ffn_conv, *ffn_w_down;
    float* out; unsigned char* ws;
};

__device__ __forceinline__ float bf2f(unsigned short h) { return __uint_as_float(((unsigned)h) << 16); }
__device__ __forceinline__ float bflo(unsigned w) { return __uint_as_float(w << 16); }
__device__ __forceinline__ float bfhi(unsigned w) { return __uint_as_float(w & 0xffff0000u); }
__device__ __forceinline__ float fast_exp2(float x) { return __builtin_amdgcn_exp2f(x); }
__device__ __forceinline__ float sigmoidf_(float x) { return 1.0f / (1.0f + __expf(-x)); }
__device__ __forceinline__ float siluf_(float x) { return x / (1.0f + __expf(-x)); }
__device__ __forceinline__ float fast_sigmoid(float x) { return __builtin_amdgcn_rcpf(1.0f + __builtin_amdgcn_exp2f(-1.4426950408889634f * x)); }
__device__ __forceinline__ float fast_silu(float x) { return x * fast_sigmoid(x); }

__device__ __forceinline__ void cvt_tile(const float* src, int ldsrc, int k0, int c0, bf16_t* dst, int lddst, int r0, float scale, LAS float* scr) {
    const int tid = otid();
    { const int n = tid & 63, kk = tid >> 6;
#pragma unroll
      for (int i = 0; i < 8; ++i) scr[(kk + 8 * i) * 65 + n] = src[(size_t)(k0 + kk + 8 * i) * ldsrc + c0 + n] * scale; }
    __syncthreads();
    { const int kp = tid & 31, nn = tid >> 5;
#pragma unroll
      for (int i = 0; i < 4; ++i) { const int n = nn + 16 * i;
          *(unsigned*)(dst + (size_t)(r0 + n) * lddst + k0 + 2 * kp) = cvt_pk_bf16(scr[(2 * kp) * 65 + n], scr[(2 * kp + 1) * 65 + n]); } }
    __syncthreads();
}
__device__ __forceinline__ void convert_layer(const Params& P, int layer, LAS unsigned char* lds) {
    LAS float* scr = (LAS float*)lds;
#ifdef DBG_KIND1
    const int kind = 1, jj = 0;
#else
    const int kind = layer % 3, jj = layer / 3;
#endif
    const int NIN = kind == 1 ? 4096 : 2560;
    const float* win = kind == 0 ? P.attn_w_in + (size_t)jj * D * 2560 : (kind == 1 ? P.hgrn_w_in + (size_t)jj * D * 4096 : P.conv_w_in + (size_t)jj * D * 2560);
#ifdef DBG_WALT
    bf16_t* Wt_in = (bf16_t*)(P.ws + (layer == 1 ? WS_OB : WS_WIN));
#else
    bf16_t* Wt_in = (bf16_t*)(P.ws + WS_WIN);
#endif
    bf16_t* Wt_o = (bf16_t*)(P.ws + WS_WO); bf16_t* Wt_up = (bf16_t*)(P.ws + WS_WUP); bf16_t* Wt_dn = (bf16_t*)(P.ws + WS_WDN);
    const int T_IN = (NIN / 64) * 16, T_O = 256, T_UP = 88 * 16, T_DN = 16 * 44, T_ALL = T_IN + T_O + T_UP + T_DN;
    for (int it = blockIdx.x; it < T_ALL; it += gridDim.x) {
        int r = it;
        if (r < T_IN) { const int nt = r >> 4, kt = r & 15; const int c0 = nt * 64;
            const bool qcol = (kind == 0 && c0 < MIXW) || (c0 >= NIN - 256);
            cvt_tile(win, NIN, kt * 64, c0, Wt_in, D, c0, qcol ? 0.125f * LOG2E : 1.0f, scr); continue; }
        r -= T_IN;
        if (r < T_O) { const int nt = r >> 4, kt = r & 15; cvt_tile(P.w_o + (size_t)layer * D * D, D, kt * 64, nt * 64, Wt_o, D, nt * 64, 1.0f, scr); continue; }
        r -= T_O;
        if (r < T_UP) { const int nt = r >> 4, kt = r & 15; const int j = nt >> 2, q = nt & 3; const int c0 = q < 2 ? j * 128 + q * 64 : DFF + j * 128 + (q - 2) * 64;
            cvt_tile(P.ffn_w_up + (size_t)layer * D * 2 * DFF, 2 * DFF, kt * 64, c0, Wt_up, D, nt * 64, 1.0f, scr); continue; }
        r -= T_UP;
        { const int nt = r / 44, kt = r % 44; cvt_tile(P.ffn_w_down + (size_t)layer * DFF * D, D, kt * 64, nt * 64, Wt_dn, DFF, nt * 64, 1.0f, scr); }
    }
}
__device__ __forceinline__ void convert_prologue(const Params& P, LAS unsigned char* lds) {
    LAS float* scr = (LAS float*)lds;
    bf16_t* Wt_kv = (bf16_t*)(P.ws + WS_WKV);
    for (int it = blockIdx.x; it < 512; it += gridDim.x) { const int l = it >> 7, r = it & 127, nt = r >> 4, kt = r & 15;
        cvt_tile(P.mem_w_kv + (size_t)l * D * 512, 512, kt * 64, nt * 64, Wt_kv, D, l * 512 + nt * 64, 1.0f, scr); }
    const size_t gt = (size_t)blockIdx.x * 512 + otid(), gs = (size_t)gridDim.x * 512;
    { const f32x4* s = (const f32x4*)P.x; u32x2* d = (u32x2*)(P.ws + WS_XB);
      for (size_t i = gt; i < (size_t)NTOK * D / 4; i += gs) { const f32x4 v = s[i]; u32x2 o; o.x = cvt_pk_bf16(v.x, v.y); o.y = cvt_pk_bf16(v.z, v.w); d[i] = o; } }
    { const f32x4* s = (const f32x4*)P.mem; u32x2* d = (u32x2*)(P.ws + WS_MEMB);
      for (size_t i = gt; i < (size_t)1024 * D / 4; i += gs) { const f32x4 v = s[i]; u32x2 o; o.x = cvt_pk_bf16(v.x, v.y); o.y = cvt_pk_bf16(v.z, v.w); d[i] = o; } }
}

struct EpiBf16P {
    static constexpr bool PERM = true, AFTER_DRAIN = false;
    bf16_t* O; int ldc; int roff = 0;
    __device__ __forceinline__ void operator()(const f32x4 (&acc)[2][2][4][2], const pg8::Unit& u, int wr, int wc, int fr, int fq) const {
        const int row0 = roff + u.pm * 256 + wr * 64 + fr, col0 = u.pn * 256 + wc * 32 + 8 * fq;
#pragma unroll
        for (int ai = 0; ai < 2; ++ai)
#pragma unroll
            for (int m = 0; m < 4; ++m) { bf16_t* rowp = O + (size_t)(row0 + ai * 128 + m * 16) * ldc + col0;
#pragma unroll
                for (int bj = 0; bj < 2; ++bj) { const f32x4 v0 = acc[ai][bj][m][0], v1 = acc[ai][bj][m][1];
                    u32x4 w; w.x = cvt_pk_bf16(v0[0], v0[1]); w.y = cvt_pk_bf16(v0[2], v0[3]); w.z = cvt_pk_bf16(v1[0], v1[1]); w.w = cvt_pk_bf16(v1[2], v1[3]);
                    *(u32x4*)(rowp + bj * 128) = w; } }
    }
};
struct EpiResid {
    static constexpr bool PERM = false, AFTER_DRAIN = false;
    float* io; const float* xin; const float* stats; const float* lg; const float* lb; int roff = 0;
    __device__ __forceinline__ void operator()(const f32x4 (&acc)[2][2][4][2], const pg8::Unit& u, int wr, int wc, int fr, int fq) const {
        const int row0 = roff + u.pm * 256 + wr * 64 + fr, col0 = u.pn * 256 + wc * 32 + 4 * fq;
#pragma unroll
        for (int bj = 0; bj < 2; ++bj)
#pragma unroll
            for (int n = 0; n < 2; ++n) {
                const int cc = col0 + bj * 128 + n * 16;
                f32x4 gv = (f32x4){1.f, 1.f, 1.f, 1.f}, bv = (f32x4){0.f, 0.f, 0.f, 0.f};
                if (stats) { gv = *(const f32x4*)(lg + cc); bv = *(const f32x4*)(lb + cc); }
#pragma unroll
                for (int ai = 0; ai < 2; ++ai)
#pragma unroll
                    for (int m = 0; m < 4; ++m) { const int row = row0 + ai * 128 + m * 16; const size_t ro = (size_t)row * D + cc;
                        f32x4 xv = *(const f32x4*)(xin + ro);
                        if (stats) { const float mean = stats[2 * row], rstd = stats[2 * row + 1]; xv = (xv - mean) * rstd * gv + bv; }
                        *(f32x4*)(io + ro) = xv * ALPHA + acc[ai][bj][m][n]; }
            }
    }
};

__device__ __forceinline__ float dpp_ror1(float x) { return __builtin_bit_cast(float, __builtin_amdgcn_update_dpp(0, __builtin_bit_cast(int, x), 0x121, 0xf, 0xf, false)); }
__device__ __forceinline__ float dpp_ror15(float x) { return __builtin_bit_cast(float, __builtin_amdgcn_update_dpp(0, __builtin_bit_cast(int, x), 0x12f, 0xf, 0xf, false)); }
struct EpiGate {
    static constexpr bool PERM = false, AFTER_DRAIN = false;
    bf16_t* g; float* edge; const float* cw; LAS unsigned char* xl;
    __device__ __forceinline__ void operator()(const f32x4 (&acc)[2][2][4][2], const pg8::Unit& u, int wr, int wc, int fr, int fq) const {
        LAS f32x4* X = (LAS f32x4*)xl;
        const int cq = wc * 8 + fq;
        if (fr == 0) {
#pragma unroll
            for (int ai = 0; ai < 2; ++ai)
#pragma unroll
                for (int bj = 0; bj < 2; ++bj)
#pragma unroll
                    for (int n = 0; n < 2; ++n) X[(((ai * 2 + wr) * 2 + 0) * 2 + bj) * 32 + cq + 4 * n] = acc[ai][bj][0][n];
        }
        if (fr == 15) {
#pragma unroll
            for (int ai = 0; ai < 2; ++ai)
#pragma unroll
                for (int bj = 0; bj < 2; ++bj)
#pragma unroll
                    for (int n = 0; n < 2; ++n) X[(((ai * 2 + wr) * 2 + 1) * 2 + bj) * 32 + cq + 4 * n] = acc[ai][bj][3][n];
        }
        asm volatile("s_waitcnt lgkmcnt(0)" ::: "memory");
        __builtin_amdgcn_s_barrier(); __builtin_amdgcn_s_barrier();
        asm volatile("" ::: "memory");
        const int colbase = u.pn * 128 + wc * 32 + 4 * fq;
        const size_t row0 = (size_t)u.pm * 256 + wr * 64 + fr;
#pragma unroll
        for (int ai = 0; ai < 2; ++ai) {
            const int seg = ai * 2 + wr;
#pragma unroll
            for (int n = 0; n < 2; ++n) {
                f32x4 h[2][4];
#pragma unroll
                for (int bj = 0; bj < 2; ++bj) {
                    f32x4 wgt[3];
#pragma unroll
                    for (int t = 0; t < 3; ++t) wgt[t] = *(const f32x4*)(cw + (size_t)t * 2 * DFF + bj * DFF + colbase + 16 * n);
                    const f32x4 hp = seg > 0 ? X[(((seg - 1) * 2 + 1) * 2 + bj) * 32 + cq + 4 * n] : (f32x4){0.f, 0.f, 0.f, 0.f};
                    const f32x4 hn = seg < 3 ? X[(((seg + 1) * 2 + 0) * 2 + bj) * 32 + cq + 4 * n] : (f32x4){0.f, 0.f, 0.f, 0.f};
#pragma unroll
                    for (int i = 0; i < 4; ++i) {
                        float R[4], L[4];
#pragma unroll
                        for (int m = 0; m < 4; ++m) { R[m] = dpp_ror1(acc[ai][bj][m][n][i]); L[m] = dpp_ror15(acc[ai][bj][m][n][i]); }
#pragma unroll
                        for (int m = 0; m < 4; ++m) {
                            const float pv_ = fr == 0 ? (m == 0 ? hp[i] : R[m == 0 ? 0 : m - 1]) : R[m];
                            const float nx_ = fr == 15 ? (m == 3 ? hn[i] : L[m == 3 ? 3 : m + 1]) : L[m];
                            h[bj][m][i] = wgt[0][i] * pv_ + wgt[1][i] * acc[ai][bj][m][n][i] + wgt[2][i] * nx_;
                        }
                    }
                    __builtin_amdgcn_sched_barrier(0);
                }
#pragma unroll
                for (int m = 0; m < 4; ++m) {
                    const f32x4 a = h[0][m], v = h[1][m];
                    u32x2 w; w.x = cvt_pk_bf16(fast_silu(a[0]) * v[0], fast_silu(a[1]) * v[1]); w.y = cvt_pk_bf16(fast_silu(a[2]) * v[2], fast_silu(a[3]) * v[3]);
                    *(u32x2*)(g + (row0 + ai * 128 + m * 16) * DFF + colbase + 16 * n) = w;
                }
                __builtin_amdgcn_sched_barrier(0);
            }
        }
        const int ecol = u.pn * 256 + wc * 32 + 4 * fq;
        if (wr == 0 && fr < 2) {
#pragma unroll
            for (int bj = 0; bj < 2; ++bj)
#pragma unroll
                for (int n = 0; n < 2; ++n) *(f32x4*)(edge + ((size_t)u.pm * 4 + fr) * (2 * DFF) + ecol + bj * 128 + 16 * n) = acc[0][bj][0][n];
        }
        if (wr == 1 && fr >= 14) {
#pragma unroll
            for (int bj = 0; bj < 2; ++bj)
#pragma unroll
                for (int n = 0; n < 2; ++n) *(f32x4*)(edge + ((size_t)u.pm * 4 + (fr - 12)) * (2 * DFF) + ecol + bj * 128 + 16 * n) = acc[1][bj][3][n];
        }
    }
};
__device__ __forceinline__ void gate_fixup(const float* edge, bf16_t* g, const float* cw) {
    const int total = 128 * 2 * DFF;
    for (int it = blockIdx.x * 512 + otid(); it < total; it += gridDim.x * 512) {
        const int c = it % DFF, rr = (it / DFF) & 1, pm = it / (2 * DFF);
        const int pn = c >> 7, cc = c & 127, ea = pn * 256 + cc, ev = ea + 128;
        const float* E = edge + (size_t)pm * 4 * (2 * DFF);
        float pa, pv_, ca, cv, na, nv;
        if (rr == 0) {
            ca = E[0 * 2 * DFF + ea]; cv = E[0 * 2 * DFF + ev]; na = E[1 * 2 * DFF + ea]; nv = E[1 * 2 * DFF + ev];
            if ((pm & 31) == 0) { pa = 0.f; pv_ = 0.f; } else { pa = (E - 4 * (2 * DFF))[3 * 2 * DFF + ea]; pv_ = (E - 4 * (2 * DFF))[3 * 2 * DFF + ev]; }
        } else {
            pa = E[2 * 2 * DFF + ea]; pv_ = E[2 * 2 * DFF + ev]; ca = E[3 * 2 * DFF + ea]; cv = E[3 * 2 * DFF + ev];
            if ((pm & 31) == 31) { na = 0.f; nv = 0.f; } else { na = (E + 4 * (2 * DFF))[0 * 2 * DFF + ea]; nv = (E + 4 * (2 * DFF))[0 * 2 * DFF + ev]; }
        }
        const float ha = cw[c] * pa + cw[2 * DFF + c] * ca + cw[4 * DFF + c] * na;
        const float hv = cw[DFF + c] * pv_ + cw[3 * DFF + c] * cv + cw[5 * DFF + c] * nv;
        const float o = fast_silu(ha) * hv;
        g[((size_t)pm * 256 + rr * 255) * DFF + c] = (bf16_t)(cvt_pk_bf16(o, 0.f) & 0xffffu);
    }
}
template <class Epi>
__device__ __forceinline__ void run_gemm(LAS unsigned char* lds, const bf16_t* A, const bf16_t* Bt, int M, int N, int K, const Epi& E) {
    pg8::StaticOrder S; S.init(M, N, (int)gridDim.x, (int)blockIdx.x);
    pg8::Gemm g; g.A = A; g.Bt = Bt; g.M = M; g.N = N; g.K = K;
    pg8::gemm_phase<Epi, pg8::StaticOrder, false>(lds, g, S, E, nullptr);
    __syncthreads();
}

template <class Epi>
__device__ __forceinline__ void run_gemm_halves(LAS unsigned char* lds, const bf16_t* A, const bf16_t* Bt, int M, int N, int K, Epi E) {
    for (int h = 0; h < 2; ++h) { E.roff = h * (M / 2); run_gemm(lds, A + (size_t)h * (M / 2) * K, Bt, M / 2, N, K, E); }
}
__device__ __forceinline__ float wave_sum(float v) {
#pragma unroll
    for (int o = 32; o >= 1; o >>= 1) v += __shfl_xor(v, o);
    return v;
}
__device__ __forceinline__ void ln_phase(float* io, bf16_t* xb, const float* gain, const float* bias, float* stats, bool wf32) {
    const int lane = otid() & 63, wid = otid() >> 6;
    f32x4 gv[4], bv[4];
#pragma unroll
    for (int j = 0; j < 4; ++j) { gv[j] = ((const f32x4*)gain)[lane + 64 * j]; bv[j] = ((const f32x4*)bias)[lane + 64 * j]; }
    for (int rg = (blockIdx.x * 8 + wid) * 4; rg < NTOK / 4; rg += gridDim.x * 8 * 4)
    for (int r0 = 0; r0 < 16; r0 += 4) {
        f32x4 v[4][4];
#pragma unroll
        for (int r = 0; r < 4; ++r) { const int row = rg * 4 + r0 + r; const f32x4* xr = (const f32x4*)(io + (size_t)row * D) + lane;
#pragma unroll
            for (int j = 0; j < 4; ++j) v[r][j] = xr[64 * j]; }
#pragma unroll
        for (int r = 0; r < 4; ++r) {
            const int row = rg * 4 + r0 + r;
            float s = 0.f;
#pragma unroll
            for (int j = 0; j < 4; ++j) s += (v[r][j].x + v[r][j].y) + (v[r][j].z + v[r][j].w);
            const float mean = wave_sum(s) * (1.f / D); float s2 = 0.f;
#pragma unroll
            for (int j = 0; j < 4; ++j) { v[r][j] = v[r][j] - mean; s2 += (v[r][j].x * v[r][j].x + v[r][j].y * v[r][j].y) + (v[r][j].z * v[r][j].z + v[r][j].w * v[r][j].w); }
            const float rstd = 1.0f / sqrtf(wave_sum(s2) * (1.f / D) + LN_EPS);
            f32x4* xr = (f32x4*)(io + (size_t)row * D) + lane; u32x2* o8 = (u32x2*)(xb + (size_t)row * D) + lane;
            if (lane == 0) { stats[2 * row] = mean; stats[2 * row + 1] = rstd; }
#pragma unroll
            for (int j = 0; j < 4; ++j) { const f32x4 y = v[r][j] * rstd * gv[j] + bv[j]; if (wf32) xr[64 * j] = y;
                u32x2 o; o.x = cvt_pk_bf16(y.x, y.y); o.y = cvt_pk_bf16(y.z, y.w); o8[64 * j] = o; }
        }
    }
}

__device__ __forceinline__ void unpack8(const u32x4 w, float (&f)[8]) {
    f[0] = bflo(w.x); f[1] = bfhi(w.x); f[2] = bflo(w.y); f[3] = bfhi(w.y); f[4] = bflo(w.z); f[5] = bfhi(w.z); f[6] = bflo(w.w); f[7] = bfhi(w.w);
}
__device__ __forceinline__ void gate_phase(const bf16_t* u, int ldu, int tile0, int ntile, bf16_t* g, const float* cw  ) {
    const int tid = otid();
    const int combo = tid & 127, sub = tid >> 7;
    const int jj = combo >> 4, cg = combo & 15;
    if (jj >= ntile) return;
    const int ca = (tile0 + jj) * 128 + cg * 8, cv = DFF + ca;
    float wa[3][8], wv[3][8];
#pragma unroll
    for (int t = 0; t < 3; ++t)
#pragma unroll
        for (int i = 0; i < 8; ++i) { wa[t][i] = cw[(size_t)t * 2 * DFF + ca + i]; wv[t][i] = cw[(size_t)t * 2 * DFF + cv + i]; }
    const u32x4 zero4 = (u32x4){0u, 0u, 0u, 0u};
    for (int strip = blockIdx.x; strip < NTOK / 32; strip += gridDim.x) {
        const int t0 = strip * 32 + sub * 8;
        const bf16_t* ua = u + (size_t)t0 * ldu + jj * 256 + cg * 8;
        u32x4 ra[10], rv[10];
#pragma unroll
        for (int r = 0; r < 10; ++r) {
            const int tt = t0 - 1 + r;
            const bool valid = !((r == 0 && (t0 & (SEQ - 1)) == 0) || (r == 9 && ((t0 + 8) & (SEQ - 1)) == 0));
            if (valid) { ra[r] = *(const u32x4*)(ua + (ptrdiff_t)(r - 1) * ldu); rv[r] = *(const u32x4*)(ua + (ptrdiff_t)(r - 1) * ldu + 128); }
            else { ra[r] = zero4; rv[r] = zero4; }
            (void)tt;
        }
#pragma unroll
        for (int t = 0; t < 8; ++t) {
            float fpa[8], fca[8], fna[8], fpv[8], fcv[8], fnv[8], o[8];
            unpack8(ra[t], fpa); unpack8(ra[t + 1], fca); unpack8(ra[t + 2], fna); unpack8(rv[t], fpv); unpack8(rv[t + 1], fcv); unpack8(rv[t + 2], fnv);
#pragma unroll
            for (int i = 0; i < 8; ++i) { const float ha = wa[0][i] * fpa[i] + wa[1][i] * fca[i] + wa[2][i] * fna[i];
                const float hv = wv[0][i] * fpv[i] + wv[1][i] * fcv[i] + wv[2][i] * fnv[i]; o[i] = siluf_(ha) * hv; }
            u32x4 w; w.x = cvt_pk_bf16(o[0], o[1]); w.y = cvt_pk_bf16(o[2], o[3]); w.z = cvt_pk_bf16(o[4], o[5]); w.w = cvt_pk_bf16(o[6], o[7]);
            *(u32x4*)(g + (size_t)(t0 + t) * DFF + ca) = w;
        }
    }
}

__device__ __forceinline__ void shortconv_phase(const bf16_t* p, int ldp, bf16_t* mix, const float* cw  ) {
    const int tid = otid();
    if (tid >= 384) return;
    const int cg = tid % 96, sub = tid / 96, c = cg * 8;
    float w[3][8];
#pragma unroll
    for (int t = 0; t < 3; ++t)
#pragma unroll
        for (int i = 0; i < 8; ++i) w[t][i] = cw[t * MIXW + c + i];
    for (int strip = blockIdx.x; strip < NTOK / 64; strip += gridDim.x) {
        const int t0 = strip * 64 + sub * 16;
        const bf16_t* pr = p + (size_t)t0 * ldp + c;
        float pp[8], pc[8], pn[8], a[8], b[8];
        if ((t0 & (SEQ - 1)) == 0) {
#pragma unroll
            for (int i = 0; i < 8; ++i) pp[i] = 0.f;
        } else { unpack8(*(const u32x4*)(pr - ldp + MIXW), a); unpack8(*(const u32x4*)(pr - ldp + 2 * MIXW), b);
#pragma unroll
            for (int i = 0; i < 8; ++i) pp[i] = a[i] * b[i]; }
        unpack8(*(const u32x4*)(pr + MIXW), a); unpack8(*(const u32x4*)(pr + 2 * MIXW), b);
#pragma unroll
        for (int i = 0; i < 8; ++i) pc[i] = a[i] * b[i];
#pragma unroll 2
        for (int t = 0; t < 16; ++t) {
            const int tt = t0 + t; const bf16_t* r = pr + (size_t)t * ldp;
            if ((tt & (SEQ - 1)) == SEQ - 1) {
#pragma unroll
                for (int i = 0; i < 8; ++i) pn[i] = 0.f;
            } else { unpack8(*(const u32x4*)(r + ldp + MIXW), a); unpack8(*(const u32x4*)(r + ldp + 2 * MIXW), b);
#pragma unroll
                for (int i = 0; i < 8; ++i) pn[i] = a[i] * b[i]; }
            float gb[8], o[8]; unpack8(*(const u32x4*)r, gb);
#pragma unroll
            for (int i = 0; i < 8; ++i) o[i] = gb[i] * (w[0][i] * pp[i] + w[1][i] * pc[i] + w[2][i] * pn[i]);
            u32x4 ow; ow.x = cvt_pk_bf16(o[0], o[1]); ow.y = cvt_pk_bf16(o[2], o[3]); ow.z = cvt_pk_bf16(o[4], o[5]); ow.w = cvt_pk_bf16(o[6], o[7]);
            *(u32x4*)(mix + (size_t)tt * D + c) = ow;
#pragma unroll
            for (int i = 0; i < 8; ++i) { pp[i] = pc[i]; pc[i] = pn[i]; }
        }
    }
}

__device__ __forceinline__ bf16x8 mk8(u32x2 lo, u32x2 hi) { u32x4 t; t.x = lo.x; t.y = lo.y; t.z = hi.x; t.w = hi.y; return __builtin_bit_cast(bf16x8, t); }
__device__ __forceinline__ f32x4 mfma16(bf16x8 a, bf16x8 b, f32x4 c) { return __builtin_amdgcn_mfma_f32_16x16x32_bf16(a, b, c, 0, 0, 0); }

__device__ __forceinline__ int t5_bucket(int rel) {
    const int n = rel < 0 ? -rel : rel; int b;
    if (n < 8) b = n; else { int lg = 2 + (31 - __clz(n * n)); b = lg > 15 ? 15 : lg; }
    return b + (rel > 0 ? 16 : 0);
}
#ifdef EXPV
__device__ int g_variant_dummy;
#endif
#ifdef ALL_LATE
#define FL_SB
#else
#define FL_SB __builtin_amdgcn_sched_barrier(0)
#endif
template <int MODE>
__device__ __forceinline__ void flash_item(int variant, LAS unsigned char* lds, const bf16_t* Qp, int ldq, const bf16_t* Kp, int ldk, const bf16_t* Vp, int ldv,
                                           int nkeys, int q0, const LAS float* btab, bf16_t* Op, const float* lamp, int layer_, const float* subln) {
    constexpr int EB = MODE ? 8 : 4, KROWB = MODE ? 256 : 128, KPITCH = KROWB + 16, VPITCH = 144, KBYTES = 64 * KPITCH, BUFB = KBYTES + EB * 16 * VPITCH;
    constexpr int KCH = KROWB / 16, NKL = 64 * KCH / 512;
    const int tid = otid(), lane = tid & 63, wid = __builtin_amdgcn_readfirstlane(tid >> 6), l15 = lane & 15, quad = lane >> 4;
    const int sub = MODE ? (wid >> 2) : 0, qrow0 = MODE ? (wid & 3) * 32 : wid * 32;
    bf16x8 Qf[2][2];
#pragma unroll
    for (int qt = 0; qt < 2; ++qt)
#pragma unroll
        for (int ks = 0; ks < 2; ++ks) Qf[qt][ks] = *(const bf16x8*)(Qp + (size_t)(qrow0 + qt * 16 + l15) * ldq + sub * 64 + ks * 32 + quad * 8);
    f32x4 O[2][EB];
#pragma unroll
    for (int qt = 0; qt < 2; ++qt)
#pragma unroll
        for (int eb = 0; eb < EB; ++eb) O[qt][eb] = (f32x4){0.f, 0.f, 0.f, 0.f};
    float lrun[2] = {0.f, 0.f}, mref[2];
    u32x4 kreg[NKL], vreg[2];
    const int veg = (EB == 8) ? ((wid & 3) * 4 + (lane & 3)) : ((wid & 1) * 4 + (lane & 3));
    const int vpair = (EB == 8) ? ((wid >> 2) * 16 + (lane >> 2)) : ((wid >> 1) * 16 + (lane >> 2));
    const bool vact = (EB == 8) || (wid < 4);
    auto gload = [&](int k0) {
#pragma unroll
        for (int i = 0; i < NKL; ++i) { const int c = tid + i * 512, chunk = c % KCH, key = c / KCH;
            kreg[i] = *(const u32x4*)(Kp + (size_t)(k0 + key) * ldk + chunk * 8); }
        if (vact) { vreg[0] = *(const u32x4*)(Vp + (size_t)(k0 + 2 * vpair) * ldv + veg * 8); vreg[1] = *(const u32x4*)(Vp + (size_t)(k0 + 2 * vpair + 1) * ldv + veg * 8); }
    };
    auto lstore = [&](int buf) {
        LAS unsigned char* kb = lds + buf * BUFB; LAS unsigned char* vb = kb + KBYTES;
#pragma unroll
        for (int i = 0; i < NKL; ++i) { const int c = tid + i * 512, chunk = c % KCH, key = c / KCH;
            *(LAS u32x4*)(kb + key * KPITCH + chunk * 16) = kreg[i]; }
        if (vact) {
            const unsigned a[4] = {vreg[0].x, vreg[0].y, vreg[0].z, vreg[0].w}, b[4] = {vreg[1].x, vreg[1].y, vreg[1].z, vreg[1].w};
            const int pl = vpair & 15, vdp = (vpair & 16) + 4 * ((pl & 7) >> 1) + 2 * (pl >> 3) + (pl & 1);
#pragma unroll
            for (int i = 0; i < 4; ++i) {
                *(LAS unsigned*)(vb + (veg * 8 + 2 * i) * VPITCH + vdp * 4) = (a[i] & 0xffffu) | (b[i] << 16);
                *(LAS unsigned*)(vb + (veg * 8 + 2 * i + 1) * VPITCH + vdp * 4) = (a[i] >> 16) | (b[i] & 0xffff0000u);
            }
        }
    };
    const int nt = nkeys / 64;
    gload(0); lstore(0); gload(64); lstore(1); __syncthreads();
    const int qlo = q0 + qrow0;
    {
        float mx0 = -INFINITY, mx1 = -INFINITY;
#pragma unroll
        for (int kb = 0; kb < 4; ++kb) {
            f32x4 S0 = (f32x4){0.f, 0.f, 0.f, 0.f}, S1 = (f32x4){0.f, 0.f, 0.f, 0.f};
#pragma unroll
            for (int ks = 0; ks < 2; ++ks) {
                const bf16x8 a = *(const LAS bf16x8*)(lds + (kb * 16 + l15) * KPITCH + sub * 128 + ks * 64 + quad * 16);
                S0 = mfma16(a, Qf[0][ks], S0); S1 = mfma16(a, Qf[1][ks], S1);
            }
            mx0 = fmaxf(mx0, fmaxf(fmaxf(S0[0], S0[1]), fmaxf(S0[2], S0[3]))); mx1 = fmaxf(mx1, fmaxf(fmaxf(S1[0], S1[1]), fmaxf(S1[2], S1[3])));
        }
        mx0 = fmaxf(mx0, __shfl_xor(mx0, 16)); mx0 = fmaxf(mx0, __shfl_xor(mx0, 32)); mx1 = fmaxf(mx1, __shfl_xor(mx1, 16)); mx1 = fmaxf(mx1, __shfl_xor(mx1, 32));
        mref[0] = mx0; mref[1] = mx1;
    }
    bf16x8 Pf[2][2];
    auto pv = [&](const LAS unsigned char* vbuf) {
#pragma unroll
        for (int g = 0; g < 2; ++g) {
            bf16x8 vf[EB];
#pragma unroll
            for (int eb = 0; eb < EB; ++eb) vf[eb] = *(const LAS bf16x8*)(vbuf + (eb * 16 + l15) * VPITCH + (32 * g + 8 * quad) * 2);
#pragma unroll
            for (int eb = 0; eb < EB; ++eb) { O[0][eb] = mfma16(vf[eb], Pf[0][g], O[0][eb]); O[1][eb] = mfma16(vf[eb], Pf[1][g], O[1][eb]); }
        }
    };
    auto sphase = [&](const LAS unsigned char* kbuf, int k0) {
        bool bnear = false; float bconst = 0.f;
        if (MODE) { if (k0 - (qlo + 31) >= 91) bconst = btab[511]; else if (qlo - (k0 + 63) >= 91) bconst = btab[0]; else bnear = true; }
        const float sh0 = bconst - mref[0], sh1 = bconst - mref[1];
        bf16x8 kf[4][2];
#pragma unroll
        for (int kb = 0; kb < 4; ++kb)
#pragma unroll
            for (int ks = 0; ks < 2; ++ks) kf[kb][ks] = *(const LAS bf16x8*)(kbuf + (kb * 16 + l15) * KPITCH + sub * 128 + ks * 64 + quad * 16);
        f32x4 S[2][4];
#pragma unroll
        for (int kb = 0; kb < 4; ++kb) { S[0][kb] = (f32x4){sh0, sh0, sh0, sh0}; S[1][kb] = (f32x4){sh1, sh1, sh1, sh1}; }
        if (MODE && bnear) {
#pragma unroll
            for (int kb = 0; kb < 4; ++kb) { const LAS float* bq = btab + (k0 + kb * 16 + quad * 4 - (qlo + l15) + 256);
#pragma unroll
                for (int j = 0; j < 4; ++j) { S[0][kb][j] += bq[j]; S[1][kb][j] += bq[j - 16]; } }
        }
#pragma unroll
        for (int kb = 0; kb < 4; ++kb)
#pragma unroll
            for (int ks = 0; ks < 2; ++ks) { S[0][kb] = mfma16(kf[kb][ks], Qf[0][ks], S[0][kb]); S[1][kb] = mfma16(kf[kb][ks], Qf[1][ks], S[1][kb]); }
#pragma unroll
        for (int qt = 0; qt < 2; ++qt) {
            float ls = 0.f;
#pragma unroll
            for (int kb = 0; kb < 4; ++kb) {
                S[qt][kb][0] = fast_exp2(S[qt][kb][0]); S[qt][kb][1] = fast_exp2(S[qt][kb][1]); S[qt][kb][2] = fast_exp2(S[qt][kb][2]); S[qt][kb][3] = fast_exp2(S[qt][kb][3]);
                ls += (S[qt][kb][0] + S[qt][kb][1]) + (S[qt][kb][2] + S[qt][kb][3]);
            }
            lrun[qt] += ls;
#pragma unroll
            for (int g = 0; g < 2; ++g) { u32x4 w; w.x = cvt_pk_bf16(S[qt][2 * g][0], S[qt][2 * g][1]); w.y = cvt_pk_bf16(S[qt][2 * g][2], S[qt][2 * g][3]);
                w.z = cvt_pk_bf16(S[qt][2 * g + 1][0], S[qt][2 * g + 1][1]); w.w = cvt_pk_bf16(S[qt][2 * g + 1][2], S[qt][2 * g + 1][3]);
                Pf[qt][g] = __builtin_bit_cast(bf16x8, w); }
        }
    };
    for (int t = 0; t < nt; t += 2) {
        const int b0 = t & 3, b1 = (t + 1) & 3, b2 = (t + 2) & 3, b3 = (t + 3) & 3;
        const bool more = t + 2 < nt;
        if (more) gload((t + 2) * 64);
        sphase(lds + b0 * BUFB, t * 64);
        pv(lds + b0 * BUFB + KBYTES);
        if (more) { lstore(b2); gload((t + 3) * 64); }
        sphase(lds + b1 * BUFB, (t + 1) * 64);
        pv(lds + b1 * BUFB + KBYTES);
        if (more) lstore(b3);
        __syncthreads();
    }
    float inv[2];
#pragma unroll
    for (int qt = 0; qt < 2; ++qt) { float l = lrun[qt]; l += __shfl_xor(l, 16); l += __shfl_xor(l, 32); inv[qt] = 1.0f / l; }
    if (MODE == 0) {
#pragma unroll
        for (int qt = 0; qt < 2; ++qt) { bf16_t* orow = Op + (size_t)(qrow0 + qt * 16 + l15) * D + quad * 4;
#pragma unroll
            for (int eb = 0; eb < EB; ++eb) { const f32x4 y = O[qt][eb] * inv[qt];
                u32x2 w; w.x = cvt_pk_bf16(y.x, y.y); w.y = cvt_pk_bf16(y.z, y.w); *(u32x2*)(orow + eb * 16) = w; } }
    } else {
        LAS f32x4* X = (LAS f32x4*)lds + (size_t)(wid & 3) * (2 * EB * 64) + lane;
        int ly = layer_; asm volatile("" : "+s"(ly));
        const float lam_init = ly == 0 ? 0.200000000f : (ly == 1 ? 0.355509068f : (ly == 2 ? 0.470713018f : 0.556058204f));
        const float outscale = 1.0f - lam_init;
        if (sub == 1) {
            float s01 = 0.f, s23 = 0.f;
            for (int i = 0; i < 64; ++i) { s01 += lamp[i] * lamp[64 + i]; s23 += lamp[128 + i] * lamp[192 + i]; }
            const float lam = expf(s01) - expf(s23) + lam_init;
#pragma unroll
            for (int qt = 0; qt < 2; ++qt)
#pragma unroll
                for (int eb = 0; eb < EB; ++eb) X[(qt * EB + eb) * 64] = O[qt][eb] * (lam * inv[qt]);
        }
        __syncthreads();
        if (sub == 0) {
#pragma unroll
            for (int qt = 0; qt < 2; ++qt) {
                f32x4 dv[EB]; float ss = 0.f;
#pragma unroll
#ifdef T_NOX
                for (int eb = 0; eb < EB; ++eb) { dv[eb] = O[qt][eb] * inv[qt];
#else
                for (int eb = 0; eb < EB; ++eb) { dv[eb] = O[qt][eb] * inv[qt] - X[(qt * EB + eb) * 64];
#endif
                    ss += (dv[eb].x * dv[eb].x + dv[eb].y * dv[eb].y) + (dv[eb].z * dv[eb].z + dv[eb].w * dv[eb].w); }
                ss += __shfl_xor(ss, 16); ss += __shfl_xor(ss, 32);
                const float r = outscale / sqrtf(ss * (1.0f / (EB * 16)) + LN_EPS);
                bf16_t* orow = Op + (size_t)(qrow0 + qt * 16 + l15) * D + quad * 4;
#pragma unroll
                for (int eb = 0; eb < EB; ++eb) { const f32x4 gsl = *(const f32x4*)(subln + eb * 16 + quad * 4); const f32x4 y = dv[eb] * r * gsl;
                    u32x2 w; w.x = cvt_pk_bf16(y.x, y.y); w.y = cvt_pk_bf16(y.z, y.w); *(u32x2*)(orow + eb * 16) = w; }
            }
        }
        __syncthreads();
    }
}

__device__ __forceinline__ void diffattn_phase(const Params& P, LAS unsigned char* lds, const bf16_t* p, bf16_t* mix, int layer, int variant = 0) {
    const int jj = layer / 3;
    const float* lp = P.attn_lambda + jj * 256;
    LAS float* btab = (LAS float*)(lds + 4 * (64 * 272 + 128 * 144));
    int cur_h = -1;
    const bool swz = gridDim.x == 256;
    for (int it = 0, item = blockIdx.x; swz ? it < 6 : item < 4 * 6 * 64; ++it, item += gridDim.x) {
        const int bh = swz ? (int)(blockIdx.x & 7) * 3 + (it >> 1) : item >> 6;
        const int qb = swz ? (int)(blockIdx.x >> 3) + 32 * (it & 1) : item & 63;
        const int b = bh / 6, h = bh % 6;
        if (h != cur_h) { __syncthreads();
            for (int i = otid(); i < 512; i += 512) btab[i] = P.rel_bias[t5_bucket(i - 256) * 6 + h] * LOG2E;
            cur_h = h; __syncthreads(); }
        const size_t tok0 = (size_t)b * SEQ + qb * 128;
        flash_item<1>(variant, lds, p + tok0 * 2560 + h * 128, 2560, p + (size_t)b * SEQ * 2560 + MIXW + h * 128, 2560, p + (size_t)b * SEQ * 2560 + 2 * MIXW + h * 128, 2560,
                      SEQ, qb * 128, btab, mix + tok0 * D + h * 128, lp, layer, P.attn_subln + jj * 128);
    }
}
__device__ __forceinline__ void memattn_phase(const Params& P, LAS unsigned char* lds, const bf16_t* p, int ldp, int xq0, bf16_t* mix, int layer, int first = 0, int stride = 0) {
    const bf16_t* kvm = (const bf16_t*)(P.ws + WS_KVM);
    if (stride == 0) { first = blockIdx.x; stride = gridDim.x; }
    for (int item = first; item < 128 * 4; item += stride) {
        const int h = item & 3, qb = item >> 2; const size_t tok0 = (size_t)qb * 256; const int b = qb >> 5;
        const bf16_t* kp = kvm + (size_t)b * 256 * 2048 + layer * 512 + h * 64;
        flash_item<0>(0, lds, p + tok0 * ldp + xq0 + h * 64, ldp, kp, 2048, kp + 256, 2048, 256, 0, nullptr, mix + tok0 * D + MIXW + h * 64, nullptr, 0, nullptr);
    }
}

__device__ __forceinline__ void hgrn_prep(const Params& P, bf16_t* p, bf16_t* QF, float* elast, int layer) {
    const size_t total = (size_t)4 * 128 * 384;
    for (size_t it = (size_t)blockIdx.x * 512 + otid(); it < total; it += (size_t)gridDim.x * 512) {
        const int cp = (int)(it % 384), chunk = (int)((it / 384) % 128), b = (int)(it / (384 * 128));
        const int c = cp * 2;
        float lb[2][2];
#pragma unroll
        for (int d = 0; d < 2; ++d)
#pragma unroll
            for (int e = 0; e < 2; ++e) { float den = 0.f, num = 0.f;
                for (int i = 0; i < 4; ++i) { const float ev = expf(P.hgrn_lb[(size_t)i * 2 * MIXW + d * MIXW + c + e]); den += ev; if (i >= 1 && i <= layer) num += ev; }
                lb[d][e] = num / den; }
        bf16_t* base = p + ((size_t)b * SEQ + chunk * 64) * 4096 + c;
        bf16_t* qf = QF + ((size_t)b * SEQ + chunk * 64) * MIXW + c;
        const float QS = 0.08838834764831845f;
        float e0 = 1.f, e1 = 1.f;
        for (int t = 0; t < 64; ++t) {
            const unsigned qw = *(const unsigned*)(base + (size_t)t * 4096), zw = *(const unsigned*)(base + (size_t)t * 4096 + 3 * MIXW);
            const float q0 = bflo(qw), q1 = bfhi(qw), z0 = bflo(zw), z1 = bfhi(zw);
            const float sg0 = fast_sigmoid(z0), sg1 = fast_sigmoid(z1);
            e0 *= lb[0][0] + (1.f - lb[0][0]) * sg0; e1 *= lb[0][1] + (1.f - lb[0][1]) * sg1;
            *(unsigned*)(qf + (size_t)t * MIXW) = cvt_pk_bf16(fast_silu(q0) * QS * e0, fast_silu(q1) * QS * e1);
            *(unsigned*)(base + (size_t)t * 4096 + 3 * MIXW) = cvt_pk_bf16((1.f - lb[0][0]) * (1.f - sg0) * __builtin_amdgcn_rcpf(e0), (1.f - lb[0][1]) * (1.f - sg1) * __builtin_amdgcn_rcpf(e1));
        }
        { float* el = elast + ((size_t)(0 * 4 + b) * 128 + chunk) * MIXW + c; el[0] = e0; el[1] = e1; }
        e0 = 1.f; e1 = 1.f;
        for (int t = 63; t >= 0; --t) {
            const unsigned qw = *(const unsigned*)(base + (size_t)t * 4096), zw = *(const unsigned*)(base + (size_t)t * 4096 + 4 * MIXW);
            const float q0 = bflo(qw), q1 = bfhi(qw), z0 = bflo(zw), z1 = bfhi(zw);
            const float sg0 = fast_sigmoid(z0), sg1 = fast_sigmoid(z1);
            e0 *= lb[1][0] + (1.f - lb[1][0]) * sg0; e1 *= lb[1][1] + (1.f - lb[1][1]) * sg1;
            *(unsigned*)(base + (size_t)t * 4096) = cvt_pk_bf16(fast_silu(q0) * QS * e0, fast_silu(q1) * QS * e1);
            *(unsigned*)(base + (size_t)t * 4096 + 4 * MIXW) = cvt_pk_bf16((1.f - lb[1][0]) * (1.f - sg0) * __builtin_amdgcn_rcpf(e0), (1.f - lb[1][1]) * (1.f - sg1) * __builtin_amdgcn_rcpf(e1));
        }
        { float* el = elast + ((size_t)(1 * 4 + b) * 128 + chunk) * MIXW + c; el[0] = e0; el[1] = e1; }
    }
}

__device__ __forceinline__ void hgrn_scan(const Params& P, LAS unsigned char* lds, const bf16_t* p, const bf16_t* QF, const float* elast, bf16_t* mix, bf16_t* OB) {
    constexpr int RP = 272, TP = 136;
    constexpr int OQ = 0, OK = 64 * RP, OKT = 2 * 64 * RP, OVT = OKT + 128 * TP, INB = OVT + 32 * TP;
    constexpr int SBB = 32 * RP, OSB = 0, INB0 = 2 * SBB;
    const int tid = otid(), lane = tid & 63, wid = tid >> 6, l15 = lane & 15, quad = lane >> 4;
    const int keg = (wid & 3) * 4 + (lane & 3), kpair = (wid >> 2) * 16 + (lane >> 2);
    const int veg = lane & 3, vpair = wid * 16 + (lane >> 2); const bool vact = wid < 2;
    const int vb = wid & 1, tb = wid >> 1;
    for (int item = blockIdx.x; item < 192; item += gridDim.x) {
        const int dir = item / 96, r = item % 96, b = r / 24, h = (r % 24) >> 2, vs = r & 3;
        const bf16_t* qsrc = dir == 0 ? QF + (size_t)b * SEQ * MIXW + h * 128 : p + (size_t)b * SEQ * 4096 + h * 128;
        const int ldqs = dir == 0 ? MIXW : 4096;
        const bf16_t* ksrc = p + (size_t)b * SEQ * 4096 + (3 + dir) * MIXW + h * 128;
        const bf16_t* vsrc = p + (size_t)b * SEQ * 4096 + MIXW + h * 128 + vs * 32;
        const float* elp = elast + (size_t)(dir * 4 + b) * 128 * MIXW + h * 128 + wid * 16 + l15;
        bf16_t* osrc = dir == 0 ? mix + (size_t)b * SEQ * D + h * 128 + vs * 32 : OB + (size_t)b * SEQ * MIXW + h * 128 + vs * 32;
        const int ldo = dir == 0 ? D : MIXW;
        u32x4 qreg[2], kreg[2], vreg[2]; float elreg = 0.f;
        auto gload = [&](int chunk) {
            const size_t t0 = (size_t)chunk * 64;
#pragma unroll
            for (int i = 0; i < 2; ++i) { const int c = tid + i * 512, ch = c & 15, row = c >> 4; qreg[i] = *(const u32x4*)(qsrc + (t0 + row) * ldqs + ch * 8); }
            kreg[0] = *(const u32x4*)(ksrc + (t0 + 2 * kpair) * 4096 + keg * 8); kreg[1] = *(const u32x4*)(ksrc + (t0 + 2 * kpair + 1) * 4096 + keg * 8);
            if (vact) { vreg[0] = *(const u32x4*)(vsrc + (t0 + 2 * vpair) * 4096 + veg * 8); vreg[1] = *(const u32x4*)(vsrc + (t0 + 2 * vpair + 1) * 4096 + veg * 8); }
            elreg = elp[(size_t)chunk * MIXW];
        };
        auto lstore = [&](int buf) {
            LAS unsigned char* bb = lds + INB0 + buf * INB;
#pragma unroll
            for (int i = 0; i < 2; ++i) { const int c = tid + i * 512, ch = c & 15, row = c >> 4; *(LAS u32x4*)(bb + OQ + row * RP + ch * 16) = qreg[i]; }
            *(LAS u32x4*)(bb + OK + (2 * kpair) * RP + keg * 16) = kreg[0]; *(LAS u32x4*)(bb + OK + (2 * kpair + 1) * RP + keg * 16) = kreg[1];
            { const unsigned a[4] = {kreg[0].x, kreg[0].y, kreg[0].z, kreg[0].w}, c2[4] = {kreg[1].x, kreg[1].y, kreg[1].z, kreg[1].w};
#pragma unroll
              for (int i = 0; i < 4; ++i) { *(LAS unsigned*)(bb + OKT + (keg * 8 + 2 * i) * TP + kpair * 4) = (a[i] & 0xffffu) | (c2[i] << 16);
                  *(LAS unsigned*)(bb + OKT + (keg * 8 + 2 * i + 1) * TP + kpair * 4) = (a[i] >> 16) | (c2[i] & 0xffff0000u); } }
            if (vact) { const unsigned a[4] = {vreg[0].x, vreg[0].y, vreg[0].z, vreg[0].w}, c2[4] = {vreg[1].x, vreg[1].y, vreg[1].z, vreg[1].w};
#pragma unroll
              for (int i = 0; i < 4; ++i) { *(LAS unsigned*)(bb + OVT + (veg * 8 + 2 * i) * TP + vpair * 4) = (a[i] & 0xffffu) | (c2[i] << 16);
                  *(LAS unsigned*)(bb + OVT + (veg * 8 + 2 * i + 1) * TP + vpair * 4) = (a[i] >> 16) | (c2[i] & 0xffff0000u); } }
        };
        for (int i = tid; i < SBB / 4; i += 512) *(LAS unsigned*)(lds + OSB + i * 4) = 0u;
        f32x4 Sacc[2] = {(f32x4){0.f, 0.f, 0.f, 0.f}, (f32x4){0.f, 0.f, 0.f, 0.f}};
        gload(dir == 0 ? 0 : 127); lstore(0); float elcur = elreg; __syncthreads();
        for (int step = 0; step < 128; ++step) {
            const int chunk = dir == 0 ? step : 127 - step;
            LAS unsigned char* bb = lds + INB0 + (step & 1) * INB; LAS unsigned char* sbc = lds + OSB + (step & 1) * SBB; LAS unsigned char* sbn = lds + OSB + ((step + 1) & 1) * SBB;
            if (step + 1 < 128) gload(dir == 0 ? step + 1 : 126 - step);
            bf16x8 Qfr[4];
#pragma unroll
            for (int ks = 0; ks < 4; ++ks) Qfr[ks] = *(const LAS bf16x8*)(bb + OQ + (tb * 16 + l15) * RP + ks * 64 + quad * 16);
            f32x4 oacc = (f32x4){0.f, 0.f, 0.f, 0.f};
#pragma unroll
#ifndef T_NOSTATE
            for (int ks = 0; ks < 4; ++ks) { const bf16x8 a = *(const LAS bf16x8*)(sbc + (vb * 16 + l15) * RP + ks * 64 + quad * 16); oacc = mfma16(a, Qfr[ks], oacc); }
#endif
            f32x4 A4[4];
#pragma unroll
            for (int sb = 0; sb < 4; ++sb) { A4[sb] = (f32x4){0.f, 0.f, 0.f, 0.f};
                const bool need = dir == 0 ? (sb <= tb) : (sb >= tb);
                if (need) {
#pragma unroll
                    for (int ks = 0; ks < 4; ++ks) { const bf16x8 a = *(const LAS bf16x8*)(bb + OK + (sb * 16 + l15) * RP + ks * 64 + quad * 16); A4[sb] = mfma16(a, Qfr[ks], A4[sb]); }
                    if (sb == tb) {
#pragma unroll
                        for (int j = 0; j < 4; ++j) { const int s = quad * 4 + j; const bool keep = dir == 0 ? (s <= l15) : (s >= l15); A4[sb][j] = keep ? A4[sb][j] : 0.f; }
                    }
                } }
#ifndef T_NOINTRA
#pragma unroll
            for (int g = 0; g < 2; ++g) { u32x4 w; w.x = cvt_pk_bf16(A4[2 * g][0], A4[2 * g][1]); w.y = cvt_pk_bf16(A4[2 * g][2], A4[2 * g][3]);
                w.z = cvt_pk_bf16(A4[2 * g + 1][0], A4[2 * g + 1][1]); w.w = cvt_pk_bf16(A4[2 * g + 1][2], A4[2 * g + 1][3]);
                const LAS unsigned char* vp = bb + OVT + (vb * 16 + l15) * TP + (32 * g + 4 * quad) * 2;
                const bf16x8 a = mk8(*(const LAS u32x2*)vp, *(const LAS u32x2*)(vp + 32));
                oacc = mfma16(a, __builtin_bit_cast(bf16x8, w), oacc); }
#endif
            { u32x2 w; w.x = cvt_pk_bf16(oacc[0], oacc[1]); w.y = cvt_pk_bf16(oacc[2], oacc[3]);
              *(u32x2*)(osrc + ((size_t)chunk * 64 + tb * 16 + l15) * ldo + vb * 16 + quad * 4) = w; }
#pragma unroll
            for (int v2 = 0; v2 < 2; ++v2) {
#pragma unroll
                for (int g = 0; g < 2; ++g) { const LAS unsigned char* vp = bb + OVT + (v2 * 16 + l15) * TP + (32 * g + 8 * quad) * 2;
                    const LAS unsigned char* kp = bb + OKT + (wid * 16 + l15) * TP + (32 * g + 8 * quad) * 2;
                    Sacc[v2] = mfma16(mk8(*(const LAS u32x2*)vp, *(const LAS u32x2*)(vp + 8)), mk8(*(const LAS u32x2*)kp, *(const LAS u32x2*)(kp + 8)), Sacc[v2]); }
                Sacc[v2] = Sacc[v2] * elcur;
#pragma unroll
                for (int j = 0; j < 4; ++j) *(LAS unsigned short*)(sbn + (v2 * 16 + quad * 4 + j) * RP + (wid * 16 + l15) * 2) = (unsigned short)(cvt_pk_bf16(Sacc[v2][j], 0.f) & 0xffffu);
            }
            if (step + 1 < 128) { lstore((step + 1) & 1); elcur = elreg; }
            __syncthreads();
        }
    }
}
__device__ __forceinline__ void hgrn_combine(const Params& P, const bf16_t* p, bf16_t* mix, const bf16_t* OB) {
    const int lane = otid() & 63, wid = otid() >> 6, grp = lane >> 4, l15 = lane & 15;
    const size_t total = (size_t)NTOK * 6 / 4;
    for (size_t it = (size_t)blockIdx.x * 8 + wid; it < total; it += (size_t)gridDim.x * 8) {
        const size_t pair = it * 4 + grp; const size_t tok = pair / 6; const int h = (int)(pair % 6); const int c = h * 128 + l15 * 8;
        float a[8], bq[8], gg[8], o[8];
        unpack8(*(const u32x4*)(mix + tok * D + c), a); unpack8(*(const u32x4*)(OB + tok * MIXW + c), bq); unpack8(*(const u32x4*)(p + tok * 4096 + 2 * MIXW + c), gg);
        float ss = 0.f;
#pragma unroll
        for (int i = 0; i < 8; ++i) { o[i] = a[i] + bq[i]; ss += o[i] * o[i]; }
        ss += __shfl_xor(ss, 1); ss += __shfl_xor(ss, 2); ss += __shfl_xor(ss, 4); ss += __shfl_xor(ss, 8);
        const float r = 1.0f / sqrtf(ss * (1.0f / 128.f) + LN_EPS);
        const f32x4 w0 = *(const f32x4*)(P.hgrn_norm + c), w1 = *(const f32x4*)(P.hgrn_norm + c + 4);
        const float wn[8] = {w0.x, w0.y, w0.z, w0.w, w1.x, w1.y, w1.z, w1.w};
#pragma unroll
        for (int i = 0; i < 8; ++i) o[i] = o[i] * r * wn[i] * fast_silu(gg[i]);
        u32x4 ow; ow.x = cvt_pk_bf16(o[0], o[1]); ow.y = cvt_pk_bf16(o[2], o[3]); ow.z = cvt_pk_bf16(o[4], o[5]); ow.w = cvt_pk_bf16(o[6], o[7]);
        *(u32x4*)(mix + tok * D + c) = ow;
    }
}


__device__ __forceinline__ void gsync(cg::grid_group& grid) {
#ifdef GSYNC_HEAVY
    asm volatile("s_waitcnt vmcnt(0) lgkmcnt(0)" ::: "memory");
    __syncthreads();
    if (otid() < 64) { __builtin_amdgcn_fence(__ATOMIC_RELEASE, "agent"); asm volatile("s_waitcnt vmcnt(0)" ::: "memory"); }
    __syncthreads();
    grid.sync();
    __builtin_amdgcn_fence(__ATOMIC_ACQUIRE, "agent");
    asm volatile("s_waitcnt vmcnt(0)" ::: "memory");
    __syncthreads();
#else
    asm volatile("s_waitcnt vmcnt(0) lgkmcnt(0)" ::: "memory");
    grid.sync();
#endif
}
#ifdef DBG_STOP
__device__ __forceinline__ void dbg_dump_bf16(float* out, const bf16_t* src, int ld) {
    for (size_t i = (size_t)blockIdx.x * 512 + otid(); i < (size_t)NTOK * D; i += (size_t)gridDim.x * 512) { const size_t t = i / D, c = i % D; float v = bf2f(src[t * ld + c]); out[i] = (v == v && fabsf(v) < 1e30f) ? v : 12345.f; }
}
__device__ __forceinline__ void dbg_san(float* out) {
    for (size_t i = (size_t)blockIdx.x * 512 + otid(); i < (size_t)NTOK * D; i += (size_t)gridDim.x * 512) { float v = out[i]; out[i] = (v == v && fabsf(v) < 1e30f) ? v : 12345.f; }
}
#define DBG_AT(n, code) if (DBG_STOP == (n)) { gsync(grid); code; return; }
#else
#define DBG_AT(n, code)
#endif
#ifdef UNFUSED_GATE
constexpr int NPH = 1 + 4 * 12 + 2;
#else
constexpr int NPH = 1 + 4 * 8 + 2;
#endif
__global__ void __launch_bounds__(512) mega_fwd(Params P, int lo, int hi, int variant) {
    extern __shared__ __attribute__((aligned(16))) unsigned char shm[];
    LAS unsigned char* lds = (LAS unsigned char*)shm;
    cg::grid_group grid = cg::this_grid();
    unsigned char* ws = P.ws;
    bf16_t* Wt_in = (bf16_t*)(ws + WS_WIN); bf16_t* Wt_o = (bf16_t*)(ws + WS_WO); bf16_t* Wt_up = (bf16_t*)(ws + WS_WUP); bf16_t* Wt_dn = (bf16_t*)(ws + WS_WDN);
    bf16_t* xb = (bf16_t*)(ws + WS_XB); bf16_t* pbuf = (bf16_t*)(ws + WS_BIG); bf16_t* mix = (bf16_t*)(ws + WS_BIG + BIG_MIX);
    bf16_t* gbuf = (bf16_t*)(ws + WS_BIG); bf16_t* ubuf = (bf16_t*)(ws + WS_BIG + BIG_U); bf16_t* OB = (bf16_t*)(ws + WS_OB);
    float* elast = (float*)(ws + WS_ELAST); float* lnst = (float*)(ws + WS_LNST);
#ifdef TIMING_DUMMY
    if (lo < 0) {
        float* sf = (float*)(ws + WS_BIG + BIG_U); bf16_t* sb = mix;
        if (variant == 10) ln_phase(sf, sb, P.ln_gain, P.ln_bias, lnst, false);
        else if (variant == 11) hgrn_prep(P, pbuf, xb, elast, 1);
        else if (variant == 12) hgrn_combine(P, pbuf, mix, OB);
        else if (variant == 13) memattn_phase(P, lds, pbuf, 2560, 2304, mix, 0);
        else if (variant == 14) convert_layer(P, 1, lds);
        else if (variant == 15) { EpiResid E; E.io = sf; E.xin = P.x; E.stats = nullptr; E.lg = nullptr; E.lb = nullptr; run_gemm(lds, mix, Wt_o, NTOK, D, D, E); }
        else if (variant == 16) { EpiResid E; E.io = sf; E.xin = P.x; E.stats = nullptr; E.lg = nullptr; E.lb = nullptr; run_gemm(lds, gbuf, Wt_dn, NTOK, D, DFF, E); }
        else if (variant == 17) shortconv_phase(pbuf, 2560, mix, P.conv_w);
        else if (variant == 18) { convert_prologue(P, lds); }
        return;
    }
#endif
    int ph = 0;
#define SEG(...) { if (ph >= lo && ph < hi) { __VA_ARGS__; if (ph + 1 < hi) gsync(grid); } ++ph; }
    SEG(convert_prologue(P, lds); convert_layer(P, 0, lds))
    for (int layer = 0; layer < 4; ++layer) {
        const int kind = layer % 3; const int NIN = kind == 1 ? 4096 : 2560;
        SEG(if (layer == 0) { EpiBf16P E; E.O = (bf16_t*)(ws + WS_KVM); E.ldc = 2048; run_gemm(lds, (const bf16_t*)(ws + WS_MEMB), (const bf16_t*)(ws + WS_WKV), 1024, 2048, D, E); }
            { EpiBf16P E; E.O = pbuf; E.ldc = NIN; run_gemm(lds, xb, Wt_in, NTOK, NIN, D, E); })
        if (kind == 1) {
            SEG(hgrn_prep(P, pbuf, xb, elast, layer))
            SEG(if ((int)gridDim.x > 192 && (int)blockIdx.x >= 192) memattn_phase(P, lds, pbuf, NIN, NIN - 256, mix, layer, (int)blockIdx.x - 192, (int)gridDim.x - 192);
                else hgrn_scan(P, lds, pbuf, xb, elast, mix, OB))
        }
        SEG(if (kind == 0) diffattn_phase(P, lds, pbuf, mix, layer, variant);
            else if (kind == 2) shortconv_phase(pbuf, 2560, mix, P.conv_w + (size_t)(layer / 3) * 3 * MIXW);
            else hgrn_combine(P, pbuf, mix, OB);
            __syncthreads();
            if (kind != 1 || (int)gridDim.x <= 192) memattn_phase(P, lds, pbuf, NIN, NIN - 256, mix, layer))
        SEG({ EpiResid E; E.io = P.out; E.xin = layer == 0 ? P.x : P.out; E.stats = layer == 0 ? nullptr : lnst; E.lg = P.ln_gain + (size_t)(layer == 0 ? 0 : layer - 1) * 2 * D + D; E.lb = P.ln_bias + (size_t)(layer == 0 ? 0 : layer - 1) * 2 * D + D;
              run_gemm_halves(lds, mix, Wt_o, NTOK, D, D, E); })
        SEG(ln_phase(P.out, xb, P.ln_gain + (size_t)layer * 2 * D, P.ln_bias + (size_t)layer * 2 * D, lnst, false))
#ifdef UNFUSED_GATE
        for (int part = 0; part < 3; ++part) {
            const int tile0 = part * 8, ntile = part < 2 ? 8 : 6;
            SEG({ EpiBf16P E; E.O = ubuf; E.ldc = ntile * 256; run_gemm(lds, xb, Wt_up + (size_t)tile0 * 256 * D, NTOK, ntile * 256, D, E); })
            SEG(gate_phase(ubuf, ntile * 256, tile0, ntile, gbuf, P.ffn_conv + (size_t)layer * 3 * 2 * DFF))
        }
#else
        SEG({ EpiGate E; E.g = gbuf; E.edge = (float*)ubuf; E.cw = P.ffn_conv + (size_t)layer * 3 * 2 * DFF; E.xl = lds + 131072; run_gemm(lds, xb, Wt_up, NTOK, 2 * DFF, D, E); })
        SEG(gate_fixup((const float*)ubuf, gbuf, P.ffn_conv + (size_t)layer * 3 * 2 * DFF))
#endif
        SEG({ EpiResid E; E.io = P.out; E.xin = P.out; E.stats = lnst; E.lg = P.ln_gain + (size_t)layer * 2 * D; E.lb = P.ln_bias + (size_t)layer * 2 * D; run_gemm_halves(lds, gbuf, Wt_dn, NTOK, D, DFF, E); })
        SEG(ln_phase(P.out, xb, P.ln_gain + (size_t)layer * 2 * D + D, P.ln_bias + (size_t)layer * 2 * D + D, lnst, layer == 3);
            if (layer + 1 < 4) convert_layer(P, layer + 1, lds))
    }
#undef SEG
}


#ifdef DBG_LAST
__global__ void dbg_dump_k(Params P, int which) {
    float* out = P.out;
    for (size_t i = (size_t)blockIdx.x * blockDim.x + threadIdx.x; i < (size_t)NTOK * D; i += (size_t)gridDim.x * blockDim.x) {
        const size_t t = i / D, c = i % D; float v;
        if (which == 0) v = out[i];
        else if (which == 1) v = bf2f(((const bf16_t*)(P.ws + WS_XB))[i]);
        else if (which == 2) v = bf2f(((const bf16_t*)(P.ws + WS_BIG))[t * 2560 + c]);
        else if (which == 3) v = bf2f(((const bf16_t*)(P.ws + WS_BIG))[t * 4096 + c]);
        else if (which == 4) v = bf2f(((const bf16_t*)(P.ws + WS_BIG + BIG_MIX))[i]);
        else if (which == 5) v = bf2f(((const bf16_t*)(P.ws + WS_WIN))[t * 128 + c]);
        else if (which == 6) v = bf2f(((const bf16_t*)(P.ws + WS_BIG))[t * 4096 + 2304 + c]);
        else if (which == 12) v = bf2f(((const bf16_t*)(P.ws + WS_BIG + BIG_MIX))[t * 1024 + (c % 768)]);
        else if (which == 13) v = bf2f(((const bf16_t*)(P.ws + WS_BIG + BIG_MIX))[t * 1024 + 768 + (c % 256)]);
        else if (which == 8) v = bf2f(((const bf16_t*)(P.ws + WS_BIG))[t * 2560 + 1024 + c]);
        else if (which == 9) v = bf2f(((const bf16_t*)(P.ws + WS_BIG))[t * 2560 + 1536 + c]);
        else if (which == 10) v = bf2f(((const bf16_t*)(P.ws + WS_KVM))[(t % 1024) * 2048 + c]);
        else if (which == 11) v = bf2f(((const bf16_t*)(P.ws + WS_KVM))[(t % 1024) * 2048 + 1024 + c]);
        else v = bf2f(((const bf16_t*)(P.ws + WS_OB))[t * 768 + (c % 768)]);
        out[i] = (v == v && fabsf(v) < 1e30f) ? v : 12345.f;
    }
}
#endif
#ifndef N_LAUNCHES
#define N_LAUNCHES 1
#endif
extern "C" void kernel_launch(void* const* d_in, const int* in_sizes, int n_in, void* d_out, int out_size, void* d_ws, size_t ws_size, hipStream_t stream) {
    static int grid_blocks = 0;
    if (grid_blocks == 0) {
        int dev = 0, cus = 0, per_cu = 0;
        (void)hipGetDevice(&dev); (void)hipDeviceGetAttribute(&cus, hipDeviceAttributeMultiprocessorCount, dev);
        (void)hipFuncSetAttribute((const void*)mega_fwd, hipFuncAttributeMaxDynamicSharedMemorySize, LDS_BYTES);
        (void)hipOccupancyMaxActiveBlocksPerMultiprocessor(&per_cu, (const void*)mega_fwd, 512, LDS_BYTES);
        if (per_cu < 1) per_cu = 1;
        grid_blocks = cus * per_cu;
        if (grid_blocks > 256) grid_blocks = 256;
        if (ws_size < WS_END || n_in != 18) { fprintf(stderr, "kernel_launch: unexpected ws_size %zu or n_in %d\n", ws_size, n_in); grid_blocks = -1; }
    }
    if (grid_blocks < 0) return;
    Params P{};
    P.x = (const float*)d_in[0]; P.mem = (const float*)d_in[1]; P.rel_bias = (const float*)d_in[2]; P.attn_w_in = (const float*)d_in[3]; P.attn_lambda = (const float*)d_in[4];
    P.attn_subln = (const float*)d_in[5]; P.hgrn_w_in = (const float*)d_in[6]; P.hgrn_lb = (const float*)d_in[7]; P.hgrn_norm = (const float*)d_in[8]; P.conv_w_in = (const float*)d_in[9];
    P.conv_w = (const float*)d_in[10]; P.mem_w_kv = (const float*)d_in[11]; P.w_o = (const float*)d_in[12]; P.ln_gain = (const float*)d_in[13]; P.ln_bias = (const float*)d_in[14];
    P.ffn_w_up = (const float*)d_in[15]; P.ffn_conv = (const float*)d_in[16]; P.ffn_w_down = (const float*)d_in[17];
    P.out = (float*)d_out; P.ws = (unsigned char*)d_ws;
    if (N_LAUNCHES == 1) {
        int lo = 0, hi = NPH, var0 = 0;
        void* args[] = {&P, &lo, &hi, &var0};
        hipError_t e = hipLaunchCooperativeKernel((const void*)mega_fwd, dim3(grid_blocks), dim3(512), args, LDS_BYTES, stream);
        if (e != hipSuccess) fprintf(stderr, "cooperative launch failed: %s (grid %d)\n", hipGetErrorString(e), grid_blocks);
    } else {
#ifdef DBG_LAST
        for (int ph = 0; ph <= DBG_LAST; ++ph) hipLaunchKernelGGL(mega_fwd, dim3(grid_blocks), dim3(512), LDS_BYTES, stream, P, ph, ph + 1, 0);
        hipLaunchKernelGGL(dbg_dump_k, dim3(1024), dim3(256), 0, stream, P, DBG_BUF);
#else
#ifdef TIMING_DUMMY
        for (int r = 0; r < 4; ++r) hipLaunchKernelGGL(mega_fwd, dim3(grid_blocks), dim3(512), LDS_BYTES, stream, P, -1, 0, TIMING_DUMMY);
#endif
        for (int ph = 0; ph < NPH; ++ph) {
#ifdef DUP_PH
            if (ph == DUP_PH) for (int r = 0; r < DUP_N; ++r) hipLaunchKernelGGL(mega_fwd, dim3(grid_blocks), dim3(512), LDS_BYTES, stream, P, ph, ph + 1, DUP_VAR);
#endif
            hipLaunchKernelGGL(mega_fwd, dim3(grid_blocks), dim3(512), LDS_BYTES, stream, P, ph, ph + 1, 0);
#ifdef DUP_PH

#endif
        }
#endif
    }
}
```
